# Optimizing an MI355X kernel written in HIP

```python
import jax, jax.numpy as jnp
from jax import lax
import numpy as np

D_MODEL = 1024
BATCH = 32
SEQ = 256
DEPTH = 2
DEC_BATCH = 2
DEC_SEQ = 4096
PAST_LEN = 512

GRID_W = 64
EPS = 1e-6
N_BRANCH = 3
FN_WIDTH = D_MODEL // 4
FN_GROUPS = 4
POOL_WINDOWS = (2, 4, 8, 16)
POOL_WIDTH = D_MODEL // 4
POOL_GC = POOL_WIDTH // len(POOL_WINDOWS)
N_HEADS = 8
QK_NOPE = D_MODEL // 16
QK_ROPE = D_MODEL // 32
V_DIM = D_MODEL // 16
Q_RANK = D_MODEL // 4
KV_RANK = D_MODEL // 8
ATT_WIDTH = N_HEADS * V_DIM
ROPE_THETA = 10000.0
Q_BLOCK = 128
IN_SIZES = (FN_WIDTH, FN_WIDTH, POOL_WIDTH, POOL_WIDTH, Q_RANK, KV_RANK, QK_ROPE, ATT_WIDTH, N_BRANCH * D_MODEL)
IN_WIDTH = sum(IN_SIZES)

kernel_name = "hybrid_fourier_pool_mla_diffusion_step"


def _rmsnorm(x, g):
    xf = x.astype(jnp.float32)
    r = lax.rsqrt(jnp.mean(xf * xf, axis=-1, keepdims=True) + EPS)
    return (xf * r).astype(x.dtype) * g


def _split_cols(p):
    parts, off = [], 0
    for s in IN_SIZES:
        parts.append(p[..., off:off + s])
        off += s
    return parts


def _axial_rope(L, dtype):
    rows = L // GRID_W
    t = jnp.arange(L)
    row = jnp.repeat(jnp.arange(rows), GRID_W).astype(jnp.float32)
    col = (t % GRID_W).astype(jnp.float32)
    half = QK_ROPE // 2
    freqs = ROPE_THETA ** (-jnp.arange(0, half, 2, dtype=jnp.float32) / half)
    ar = row[:, None] * freqs
    ac = col[:, None] * freqs
    cos = jnp.concatenate([jnp.cos(ar), jnp.cos(ar), jnp.cos(ac), jnp.cos(ac)], axis=-1)
    sin = jnp.concatenate([jnp.sin(ar), jnp.sin(ar), jnp.sin(ac), jnp.sin(ac)], axis=-1)
    return cos.astype(dtype), sin.astype(dtype)


def _rot_half(x):
    h = x.shape[-1] // 2
    return jnp.concatenate([-x[..., h:], x[..., :h]], axis=-1)


def _apply_rope(x, cos, sin):
    half = QK_ROPE // 2
    rx = jnp.concatenate([_rot_half(x[..., :half]), _rot_half(x[..., half:])], axis=-1)
    return x * cos + rx * sin


def _fourier_mix(u):
    B, L, _ = u.shape
    ug = u.reshape(B, L, FN_GROUPS, FN_WIDTH // FN_GROUPS).astype(jnp.float32)
    f = jnp.fft.fft2(ug, axes=(1, 3), norm="ortho").real
    return f.reshape(B, L, FN_WIDTH).astype(u.dtype)


def _pool_mix(u, pool_w, pool_scale):
    B, L, _ = u.shape
    uf = u.astype(jnp.float32)
    cs = jnp.concatenate([jnp.zeros((B, 1, POOL_WIDTH), jnp.float32), jnp.cumsum(uf, axis=1)], axis=1)
    t = jnp.arange(L)
    outs = []
    for gi, w in enumerate(POOL_WINDOWS):
        left = w // 2
        right = w - 1 - left
        lo = jnp.clip(t - left, 0, L - 1)
        hi = jnp.clip(t + right, 0, L - 1)
        cnt = (hi - lo + 1).astype(jnp.float32)
        csg = cs[..., gi * POOL_GC:(gi + 1) * POOL_GC]
        outs.append((csg[:, hi + 1] - csg[:, lo]) / cnt[None, :, None])
    pooled = (jnp.concatenate(outs, axis=-1) - uf).astype(u.dtype)
    pg = pooled.reshape(B, L, len(POOL_WINDOWS), POOL_GC)
    mixed = jnp.einsum('blgc,gcd->blgd', pg, pool_w).reshape(B, L, POOL_WIDTH)
    return mixed * pool_scale


def _block_attention(q, k, v):
    B, Lq, H, Dq = q.shape
    nb = Lq // Q_BLOCK
    qb = q.reshape(B, nb, Q_BLOCK, H, Dq).transpose(1, 0, 2, 3, 4)
    scale = Dq ** -0.5

    def one(qblk):
        s = jnp.einsum('bqhd,bkhd->bhqk', qblk, k, preferred_element_type=jnp.float32) * scale
        p = jax.nn.softmax(s, axis=-1).astype(v.dtype)
        return jnp.einsum('bhqk,bkhd->bqhd', p, v)

    o = lax.map(one, qb)
    return o.transpose(1, 0, 2, 3, 4).reshape(B, Lq, H, v.shape[-1])


def _layer(h, mod, w, rope, ctx):
    B, L, _ = h.shape
    shift, scale, gate = jnp.split(mod, 3, axis=-1)
    xn = _rmsnorm(h, w['norm_g']) * (1.0 + scale[..., None, :]) + shift[..., None, :]
    a_in, a_z, b_in, b_z, q_lat, kv_lat, k_rope, c_z, g_all = _split_cols(xn @ w['w_in'])

    ya = (_fourier_mix(a_in) * jax.nn.silu(a_z)) @ w['w_br_a']
    yb = (_pool_mix(b_in, w['pool_w'], w['pool_scale']) * jax.nn.silu(b_z)) @ w['w_br_b']

    q = (_rmsnorm(q_lat, w['q_norm_g']) @ w['w_q_up']).reshape(B, L, N_HEADS, QK_NOPE + QK_ROPE)
    q_nope, q_rope = q[..., :QK_NOPE], q[..., QK_NOPE:]
    ckv = _rmsnorm(kv_lat, w['kv_norm_g'])
    if rope is not None:
        cos, sin = rope
        q_rope = _apply_rope(q_rope, cos[:, None, :], sin[:, None, :])
        k_rope_p = _apply_rope(k_rope, cos, sin)
    else:
        k_rope_p = k_rope
    q_full = jnp.concatenate([q_nope, q_rope], axis=-1)
    if ctx is not None:
        ckv_all = jnp.concatenate([ckv, ctx[0]], axis=1)
        kr_all = jnp.concatenate([k_rope_p, ctx[1]], axis=1)
    else:
        ckv_all, kr_all = ckv, k_rope_p
    Lk = ckv_all.shape[1]
    kv = (ckv_all @ w['w_kv_up']).reshape(B, Lk, N_HEADS, QK_NOPE + V_DIM)
    k_nope, v = kv[..., :QK_NOPE], kv[..., QK_NOPE:]
    k = jnp.concatenate([k_nope, jnp.broadcast_to(kr_all[:, :, None, :], (B, Lk, N_HEADS, QK_ROPE))], axis=-1)
    o = _block_attention(q_full, k, v).reshape(B, L, ATT_WIDTH)
    yc = (o * jax.nn.silu(c_z)) @ w['w_br_c']

    g = jax.nn.sigmoid(g_all).reshape(B, L, N_BRANCH, D_MODEL)
    y = g[:, :, 0] * ya + g[:, :, 1] * yb + g[:, :, 2] * yc
    h_new = h + gate[..., None, :] * (y @ w['w_out'])
    return h_new, ckv, k_rope


def setup_inputs(seed: int = 0) -> dict:
    key = jax.random.key(seed)
    ks = jax.random.split(key, 24)
    f32 = jnp.float32

    def nrm(k, shape, s):
        return jax.random.normal(k, shape, f32) * s

    return {
        'x_prompt': nrm(ks[0], (BATCH, SEQ, D_MODEL), 1.0),
        'x_sample': nrm(ks[1], (DEC_BATCH, DEC_SEQ, D_MODEL), 1.0),
        'cache_ckv': nrm(ks[2], (DEC_BATCH, DEPTH, PAST_LEN, KV_RANK), 1.0),
        'cache_krope': nrm(ks[3], (DEC_BATCH, DEPTH, PAST_LEN, QK_ROPE), 1.0),
        'c': nrm(ks[4], (DEC_BATCH, D_MODEL), 1.0),
        'c_ctx': nrm(ks[5], (D_MODEL,), 1.0),
        'norm_g': 1.0 + nrm(ks[6], (DEPTH, D_MODEL), 0.02),
        'w_mod': nrm(ks[7], (DEPTH, D_MODEL, 3 * D_MODEL), 0.5 * D_MODEL ** -0.5),
        'b_mod': nrm(ks[8], (DEPTH, 3 * D_MODEL), 0.01),
        'w_in': nrm(ks[9], (DEPTH, D_MODEL, IN_WIDTH), D_MODEL ** -0.5),
        'pool_w': nrm(ks[10], (DEPTH, len(POOL_WINDOWS), POOL_GC, POOL_GC), POOL_GC ** -0.5),
        'pool_scale': 1.0 + nrm(ks[11], (DEPTH, POOL_WIDTH), 0.02),
        'q_norm_g': 1.0 + nrm(ks[12], (DEPTH, Q_RANK), 0.02),
        'w_q_up': nrm(ks[13], (DEPTH, Q_RANK, N_HEADS * (QK_NOPE + QK_ROPE)), Q_RANK ** -0.5),
        'kv_norm_g': 1.0 + nrm(ks[14], (DEPTH, KV_RANK), 0.02),
        'w_kv_up': nrm(ks[15], (DEPTH, KV_RANK, N_HEADS * (QK_NOPE + V_DIM)), KV_RANK ** -0.5),
        'w_br_a': nrm(ks[16], (DEPTH, FN_WIDTH, D_MODEL), FN_WIDTH ** -0.5),
        'w_br_b': nrm(ks[17], (DEPTH, POOL_WIDTH, D_MODEL), POOL_WIDTH ** -0.5),
        'w_br_c': nrm(ks[18], (DEPTH, ATT_WIDTH, D_MODEL), ATT_WIDTH ** -0.5),
        'w_out': nrm(ks[19], (DEPTH, D_MODEL, D_MODEL), D_MODEL ** -0.5),
        'final_norm_g': 1.0 + nrm(ks[20], (D_MODEL,), 0.02),
    }


def reference(x_prompt, x_sample, cache_ckv, cache_krope, c, c_ctx, norm_g, w_mod, b_mod, w_in, pool_w,
              pool_scale, q_norm_g, w_q_up, kv_norm_g, w_kv_up, w_br_a, w_br_b, w_br_c, w_out, final_norm_g):
    rope = _axial_rope(x_sample.shape[1], x_sample.dtype)
    hp, hs = x_prompt, x_sample
    ckv_list, kr_list = [], []
    for l in range(DEPTH):
        w = {'norm_g': norm_g[l], 'w_in': w_in[l], 'pool_w': pool_w[l], 'pool_scale': pool_scale[l],
             'q_norm_g': q_norm_g[l], 'w_q_up': w_q_up[l], 'kv_norm_g': kv_norm_g[l], 'w_kv_up': w_kv_up[l],
             'w_br_a': w_br_a[l], 'w_br_b': w_br_b[l], 'w_br_c': w_br_c[l], 'w_out': w_out[l]}
        mod_ctx = jax.nn.silu(c_ctx) @ w_mod[l] + b_mod[l]
        mod_lat = jax.nn.silu(c) @ w_mod[l] + b_mod[l]
        hp, ckv_l, kr_l = _layer(hp, mod_ctx, w, None, None)
        ckv_list.append(ckv_l)
        kr_list.append(kr_l)
        hs, _, _ = _layer(hs, mod_lat, w, rope, (cache_ckv[:, l], cache_krope[:, l]))
    y_prompt = _rmsnorm(hp, final_norm_g)
    y_sample = _rmsnorm(hs, final_norm_g)
    new_ckv = jnp.stack(ckv_list, axis=1)
    new_krope = jnp.stack(kr_list, axis=1)
    return (y_prompt, y_sample, new_ckv, new_krope)
```

```cpp
#include <hip/hip_runtime.h>
#include <hip/hip_cooperative_groups.h>
#include <cstdio>
#include <cstdint>
namespace cg = cooperative_groups;

#define DI __device__ __forceinline__
typedef unsigned short bf16_t;
typedef short bf16x8 __attribute__((ext_vector_type(8)));
typedef float f32x16 __attribute__((ext_vector_type(16)));
typedef float f32x4 __attribute__((ext_vector_type(4)));
typedef float f32x2 __attribute__((ext_vector_type(2)));
typedef unsigned u32x4 __attribute__((ext_vector_type(4)));
typedef unsigned u32x2 __attribute__((ext_vector_type(2)));
typedef __bf16 bf16x2_t __attribute__((ext_vector_type(2)));

constexpr int NTHR = 512, NWAVE = 8;
constexpr int D = 1024, NTOK = 16384, NPT = 8192, LP = 256, LS = 4096, LKS = 4608, PAST = 512;
constexpr int NEXT = 2208, NEXTP = 2304, PW = 1280, LATW = 416;
constexpr int LDX = 1024;
constexpr int PC_AZ = 0, PC_BIN = 256, PC_BZ = 512, PC_CZ = 768;
constexpr int NROWS_KV = NTOK + 2 * PAST;
constexpr float EPS = 1e-6f;
constexpr float QSCALE = 0.10206207261596577f * 1.4426950408889634f;

constexpr size_t al256(size_t x) { return (x + 255) & ~(size_t)255; }
constexpr size_t OFF_WINT = 0;
constexpr size_t OFF_WGT = OFF_WINT + al256((size_t)2 * NEXTP * LDX * 2);
constexpr size_t OFF_WQT = OFF_WGT + al256((size_t)2 * 3072 * LDX * 2);
constexpr size_t OFF_WKVT = OFF_WQT + al256((size_t)2 * 768 * 256 * 2);
constexpr size_t OFF_WBRT = OFF_WKVT + al256((size_t)2 * 1024 * 128 * 2);
constexpr size_t OFF_WOUTT = OFF_WBRT + al256((size_t)2 * 1024 * 1024 * 2);
constexpr size_t OFF_POOLWT = OFF_WOUTT + al256((size_t)2 * 1024 * 1024 * 2);
constexpr size_t OFF_MODP = OFF_POOLWT + al256((size_t)2 * 256 * 256 * 2);
constexpr size_t OFF_MODF = OFF_MODP + al256((size_t)16 * 2 * 3 * 3072 * 4);
constexpr size_t OFF_ROPE = OFF_MODF + al256((size_t)2 * 3 * 3072 * 4);
constexpr size_t OFF_DP = OFF_ROPE + al256((size_t)2 * 4096 * 32 * 4);
constexpr size_t OFF_A1 = OFF_DP + al256((size_t)256 * 512 * 2);
constexpr size_t OFF_D2 = OFF_A1 + al256((size_t)256 * 256 * 2);
constexpr size_t OFF_XN = OFF_D2 + al256((size_t)16 * 256 * 512 * 2);
constexpr size_t OFF_P = OFF_XN + al256((size_t)NTOK * LDX * 2);
constexpr size_t OFF_X = OFF_P + al256((size_t)NTOK * PW * 2);
constexpr size_t OFF_LAT = OFF_X;
constexpr size_t OFF_ATP = OFF_X + al256((size_t)NTOK * 1024 * 2);
constexpr size_t OFF_G = OFF_ATP;
constexpr size_t OFF_Z = OFF_ATP + al256((size_t)32 * 256 * 512 * 2);
constexpr size_t OFF_Y1 = OFF_Z + al256((size_t)2 * 256 * 64 * 128 * 2);
constexpr size_t OFF_QN = OFF_Y1 + al256((size_t)2 * 256 * 64 * 128 * 2);
constexpr size_t OFF_CKVB = OFF_QN + al256((size_t)NTOK * 256 * 2);
constexpr size_t OFF_Q = OFF_CKVB + al256((size_t)NROWS_KV * 128 * 2);
constexpr size_t OFF_Y = OFF_Q;
constexpr size_t OFF_KP = OFF_Q + al256((size_t)NTOK * 8 * 96 * 2);
constexpr size_t OFF_KS = OFF_KP + al256((size_t)32 * 8 * 256 * 64 * 2);
constexpr size_t OFF_KR = OFF_KS + al256((size_t)2 * 8 * LKS * 64 * 2);
constexpr size_t OFF_VTP = OFF_KR + al256((size_t)(NPT + 2 * LKS) * 32 * 2);
constexpr size_t OFF_VTS = OFF_VTP + al256((size_t)32 * 8 * 64 * 256 * 2);
constexpr size_t OFF_PB = OFF_VTS + al256((size_t)2 * 8 * 64 * LKS * 2);
constexpr size_t OFF_CTR = OFF_PB + al256((size_t)NTOK * 256 * 2);
constexpr size_t OFF_BAR = OFF_CTR + 256;
constexpr size_t BAR_BYTES = 3456 * 4;
constexpr size_t WS_TOTAL = OFF_BAR + al256(BAR_BYTES);
static_assert(OFF_KS - OFF_Q >= (size_t)NTOK * 1024 * 2, "Y overlay");
static_assert(OFF_CKVB - OFF_ATP >= (size_t)NTOK * 1024 * 2, "G overlay");
static_assert(OFF_CTR - OFF_KS >= (size_t)NTOK * 1024 * 2 && OFF_X - OFF_P >= (size_t)NTOK * 1024 * 2, "G1/G2 overlays");
static_assert((size_t)NTOK * LATW * 4 <= (size_t)NTOK * 1024 * 2, "LAT overlay");
static_assert(WS_TOTAL <= (size_t)256 * 1024 * 1024, "workspace");

constexpr long OUT_CKV = (long)NTOK * 1024;
constexpr long OUT_KR = OUT_CKV + (long)32 * 2 * 256 * 128;

struct Params {
  const float *x_prompt, *x_sample, *cache_ckv, *cache_krope, *c, *c_ctx, *norm_g, *w_mod, *b_mod, *w_in, *pool_w, *pool_scale,
      *q_norm_g, *w_q_up, *kv_norm_g, *w_kv_up, *w_br_a, *w_br_b, *w_br_c, *w_out, *final_norm_g;
  float* out;
  unsigned char* ws;
  int ph_lo, ph_hi;
};

DI unsigned pk_bf16(float lo, float hi) { f32x2 v = {lo, hi}; bf16x2_t r = __builtin_convertvector(v, bf16x2_t); return __builtin_bit_cast(unsigned, r); }
DI bf16_t f2bf(float x) { return (bf16_t)(pk_bf16(x, 0.f) & 0xffffu); }
DI float bf_lo(unsigned u) { return __uint_as_float(u << 16); }
DI float bf2f_(bf16_t u) { return __uint_as_float(((unsigned)u) << 16); }
DI float bf_hi(unsigned u) { return __uint_as_float(u & 0xffff0000u); }
DI float sigmoid_f(float x) { return __builtin_amdgcn_rcpf(1.f + __expf(-x)); }
DI float silu_f(float x) { return x * sigmoid_f(x); }
DI float wave_sum(float v) {
#pragma unroll
  for (int o = 32; o > 0; o >>= 1) v += __shfl_xor(v, o);
  return v;
}
DI int hide_tid() { int t = threadIdx.x; asm volatile("" : "+v"(t)); return t; }
DI int virt_block() { const int g8 = gridDim.x >> 3; return (blockIdx.x & 7) * g8 + (blockIdx.x >> 3); }
DI void tile_decode(int u, int NT, int& mt, int& nt) { const int gm = u / (8 * NT), r = u - gm * 8 * NT; nt = r >> 3; mt = gm * 8 + (r & 7); }
DI int tok_mod_idx(int t) { return t < NPT ? 0 : 1 + ((t - NPT) >> 12); }

#define LDSP __attribute__((address_space(3)))
constexpr int GM_STAGE = 65536, GM_BOFF = 32768;
DI void gemm_dma(int tid, const bf16_t* __restrict__ A, long lda, const bf16_t* __restrict__ Bt, long ldb, int k0, unsigned char* st) {
  const int wave = tid >> 6, lane = tid & 63, rl = lane >> 3, slot = lane & 7;
#pragma unroll
  for (int q = 0; q < 4; ++q) {
    const int r = 64 * q + 8 * wave + rl;
    const int ch = slot ^ ((r >> 1) & 7);
    unsigned char* dst = st + (8 * q + wave) * 1024;
    __builtin_amdgcn_global_load_lds((const unsigned*)(A + (long)r * lda + k0 + ch * 8), (LDSP unsigned*)dst, 16, 0, 0);
    __builtin_amdgcn_global_load_lds((const unsigned*)(Bt + (long)r * ldb + k0 + ch * 8), (LDSP unsigned*)(dst + GM_BOFF), 16, 0, 0);
  }
}
DI void gemm_dma_b(int tid, const bf16_t* __restrict__ Bt, long ldb, int k0, unsigned char* st) {
  const int wave = tid >> 6, lane = tid & 63, rl = lane >> 3, slot = lane & 7;
#pragma unroll
  for (int q = 0; q < 4; ++q) {
    const int r = 64 * q + 8 * wave + rl;
    const int ch = slot ^ ((r >> 1) & 7);
    __builtin_amdgcn_global_load_lds((const unsigned*)(Bt + (long)r * ldb + k0 + ch * 8), (LDSP unsigned*)(st + (8 * q + wave) * 1024 + GM_BOFF), 16, 0, 0);
  }
}
DI void gemm_compute(int tid, const unsigned char* st, f32x16 (&acc)[4][2]) {
  const int wave = tid >> 6, lane = tid & 63, wm = wave >> 2, wn = wave & 3, r = lane & 31, hh = lane >> 5;
#pragma unroll
  for (int s = 0; s < 4; ++s) {
    const int sw = ((2 * s + hh) ^ ((r >> 1) & 7)) << 4;
    bf16x8 af[4], bf[2];
#pragma unroll
    for (int i = 0; i < 4; ++i) af[i] = *(const bf16x8*)(st + (wm * 128 + i * 32 + r) * 128 + sw);
#pragma unroll
    for (int i = 0; i < 2; ++i) bf[i] = *(const bf16x8*)(st + GM_BOFF + (wn * 64 + i * 32 + r) * 128 + sw);
#pragma unroll
    for (int mi = 0; mi < 4; ++mi)
#pragma unroll
      for (int ni = 0; ni < 2; ++ni) acc[mi][ni] = __builtin_amdgcn_mfma_f32_32x32x16_bf16(bf[ni], af[mi], acc[mi][ni], 0, 0, 0);
  }
}
DI void gemm_main(int tid, const bf16_t* __restrict__ A, long lda, const bf16_t* __restrict__ Bt, long ldb, int K, f32x16 (&acc)[4][2], unsigned char* smem) {
  const int nk = K >> 6;
  gemm_dma(tid, A, lda, Bt, ldb, 0, smem);
  asm volatile("s_waitcnt vmcnt(0)" ::: "memory");
  __syncthreads();
  for (int kt = 0; kt < nk; ++kt) {
    if (kt + 1 < nk) gemm_dma(tid, A, lda, Bt, ldb, (kt + 1) * 64, smem + ((kt + 1) & 1) * GM_STAGE);
    gemm_compute(tid, smem + (kt & 1) * GM_STAGE, acc);
    asm volatile("s_waitcnt vmcnt(0)" ::: "memory");
    __syncthreads();
  }
}
DI void acc_zero(f32x16 (&acc)[4][2]) {
#pragma unroll
  for (int a = 0; a < 4; ++a)
#pragma unroll
    for (int b = 0; b < 2; ++b)
#pragma unroll
      for (int i = 0; i < 16; ++i) acc[a][b][i] = 0.f;
}
template <class F> DI void epi_blocks(int tid, const f32x16 (&acc)[4][2], int m0, int n0, F f) {
  const int wave = tid >> 6, lane = tid & 63, wm = wave >> 2, wn = wave & 3, r = lane & 31, hh = lane >> 5;
#pragma unroll
  for (int mi = 0; mi < 4; ++mi)
#pragma unroll
    for (int ni = 0; ni < 2; ++ni) f(m0 + wm * 128 + mi * 32 + r, n0 + wn * 64 + ni * 32, hh, acc[mi][ni]);
}

namespace pg8 {
#define PG8_LAS __attribute__((address_space(3)))
typedef float f32x4 __attribute__((ext_vector_type(4)));
constexpr int BM = 256, BK = 64, HALF = 128, HTB = HALF * BK * 2, STAGE_BYTES = 8 * HTB, NXCD = 8, WGM = 8;
__host__ __device__ __forceinline__ int lds_byte(int r, int c) { const int st = (r >> 4) * 2 + (c >> 5), rr = r & 15, cc = c & 31, ob = rr * 64 + cc * 2; return st * 1024 + (ob ^ (((ob >> 9) & 1) << 5)); }
__host__ __device__ __forceinline__ void stage_rc(int b, int& R, int& C) { const int st = b / 1024, sb = b % 1024, swz = sb ^ (((sb >> 9) & 1) << 5); R = (st >> 1) * 16 + swz / 64; C = (st & 1) * 32 + (swz % 64) / 2; }
__host__ __device__ __forceinline__ int perm32(int rho) { const int n = rho >> 4, i = rho & 15; return 8 * (i >> 2) + 4 * n + (i & 3); }
struct Unit { int pm, pn; int koff = 0, K = 0; };
struct Gemm { const bf16_t* A; const bf16_t* Bt; int M, N, K; int lda, ldb; };
struct StaticOrder {
    int nM, nN, nwg, G, c;
    __host__ __device__ void init(int M, int N, int G_, int c_) { nM = M / BM; nN = N / BM; nwg = nM * nN; G = G_; c = c_; }
    __host__ __device__ bool next(int i, Unit& u) const {
        const long L = (long)i * G + c; if (L >= nwg) return false;
        int wgid = (int)L; { const int q = nwg / NXCD, r = nwg % NXCD, xcd = wgid % NXCD, off = wgid / NXCD; wgid = (xcd < r ? xcd * (q + 1) : r * (q + 1) + (xcd - r) * q) + off; }
        const int nig = WGM * nN, gid = wgid / nig, fm = gid * WGM, gsz = (nM - fm) < WGM ? (nM - fm) : WGM;
        u.pm = fm + ((wgid % nig) % gsz); u.pn = (wgid % nig) / gsz; return true;
    }
    __device__ __forceinline__ void a_ready(const Unit&) const {}
    __device__ __forceinline__ void done(const Unit&) const {}
};
template <class Epi, class Sched, bool ALIGN_EPI = false, bool SP2 = false>
__device__ __forceinline__ void gemm_phase(PG8_LAS unsigned char* lds, const Gemm g, const Sched& S, const Epi& E) {
    int tid = threadIdx.x;
    asm volatile("" : "+v"(tid));
    const int wid = __builtin_amdgcn_readfirstlane(tid >> 6), lane = tid & 63, wr = wid >> 2, wc = wid & 3, fr = lane & 15, fq = lane >> 4;
    int K = g.K;
    asm volatile("" : "+s"(K));
    int nt = K / BK;
    unsigned voffA[2], voffB[2];
#pragma unroll
    for (int i = 0; i < 2; ++i) { int R, C; stage_rc(tid * 16 + i * 8192, R, C); const int Rb = Epi::PERM ? ((R & ~31) + perm32(R & 31)) : R;
        voffA[i] = (unsigned)(R * g.lda + C) * 2u; voffB[i] = (unsigned)(Rb * g.ldb + C) * 2u; }
    const size_t kstep = (size_t)(BK * 2);
    const size_t hstepA = (size_t)HALF * g.lda * 2, hstepB = (size_t)HALF * g.ldb * 2;
    const size_t tstepA = 2 * hstepA, tstepB = 2 * hstepB;
    const unsigned ldsw = (unsigned)wid * 1024u;
    const int aoff = lds_byte(wr * 64 + fr, fq * 8), boff = lds_byte(wc * 32 + fr, fq * 8);
#define PG8_SA(b, h) (((b) * 2 + (h)) * HTB)
#define PG8_SB(b, h) ((4 + (b) * 2 + (h)) * HTB)
#define PG8_STAGE(bufoff, gbase, voff) do { _Pragma("unroll") for (int _i = 0; _i < 2; ++_i) \
        __builtin_amdgcn_global_load_lds((const unsigned*)((const char*)(gbase) + (voff)[_i]), (PG8_LAS unsigned*)(lds + (bufoff) + ldsw + _i * 8192), 16, 0, 0); } while (0)
#define PG8_LDA(dst, b, h) do { _Pragma("unroll") for (int m = 0; m < 4; ++m) _Pragma("unroll") for (int k = 0; k < 2; ++k) dst[m][k] = *(const PG8_LAS bf16x8*)(lds + PG8_SA(b, h) + aoff + m * 2048 + k * 1024); } while (0)
#define PG8_LDB(dst, b, h) do { _Pragma("unroll") for (int n = 0; n < 2; ++n) _Pragma("unroll") for (int k = 0; k < 2; ++k) dst[n][k] = *(const PG8_LAS bf16x8*)(lds + PG8_SB(b, h) + boff + n * 2048 + k * 1024); } while (0)
#define PG8_MMA(ai, bj, At, Bt) do { __builtin_amdgcn_s_setprio(1); _Pragma("unroll") for (int m = 0; m < 4; ++m) _Pragma("unroll") for (int n = 0; n < 2; ++n) _Pragma("unroll") for (int k = 0; k < 2; ++k) \
        acc[ai][bj][m][n] = __builtin_amdgcn_mfma_f32_16x16x32_bf16(Bt[n][k], At[m][k], acc[ai][bj][m][n], 0, 0, 0); __builtin_amdgcn_s_setprio(0); } while (0)
#define PG8_WAIT_V(n) asm volatile("s_waitcnt vmcnt(" #n ")" ::: "memory")
#define PG8_WAIT_L(n) asm volatile("s_waitcnt lgkmcnt(" #n ")" ::: "memory")
#define PG8_BAR __builtin_amdgcn_s_barrier()
#define PG8_SCHED __builtin_amdgcn_sched_barrier(0)
    Unit cur, nxt; int ui = 0;
    if (!S.next(0, cur)) return;
    f32x4 acc[2][2][4][2];
#pragma unroll
    for (int a = 0; a < 2; ++a)
#pragma unroll
        for (int b = 0; b < 2; ++b)
#pragma unroll
            for (int m = 0; m < 4; ++m)
#pragma unroll
                for (int n = 0; n < 2; ++n) acc[a][b][m][n] = (f32x4){0.f, 0.f, 0.f, 0.f};
    bf16x8 At[4][2], B0[2][2], B1[2][2];
    if (cur.K) nt = cur.K / BK;
    const char* cA = (const char*)g.A + (size_t)cur.pm * tstepA + (size_t)cur.koff * 2; const char* cB = (const char*)g.Bt + (size_t)cur.pn * tstepB + (size_t)cur.koff * 2;
    S.a_ready(cur);
    if constexpr (SP2) {
        PG8_STAGE(PG8_SB(0, 0), cB, voffB); PG8_STAGE(PG8_SB(0, 1), cB + hstepB, voffB); PG8_STAGE(PG8_SA(0, 0), cA, voffA); PG8_STAGE(PG8_SA(0, 1), cA + hstepA, voffA);
        if (wr == 1) PG8_BAR;
        PG8_WAIT_V(2); PG8_BAR;
        PG8_STAGE(PG8_SB(1, 0), cB + kstep, voffB); PG8_STAGE(PG8_SA(1, 0), cA + kstep, voffA); PG8_STAGE(PG8_SB(1, 1), cB + hstepB + kstep, voffB);
        PG8_WAIT_V(6); PG8_BAR;
    } else {
        PG8_STAGE(PG8_SB(0, 0), cB, voffB); PG8_STAGE(PG8_SA(0, 0), cA, voffA); PG8_STAGE(PG8_SB(0, 1), cB + hstepB, voffB); PG8_STAGE(PG8_SA(0, 1), cA + hstepA, voffA);
        if (wr == 1) PG8_BAR;
        PG8_WAIT_V(4); PG8_BAR;
        PG8_STAGE(PG8_SB(1, 0), cB + kstep, voffB); PG8_STAGE(PG8_SA(1, 0), cA + kstep, voffA); PG8_STAGE(PG8_SB(1, 1), cB + hstepB + kstep, voffB);
        PG8_WAIT_V(6); PG8_BAR;
    }
    for (;;) {
        const bool has_next = S.next(ui + 1, nxt);
        const char* nA = has_next ? (const char*)g.A + (size_t)nxt.pm * tstepA + (size_t)nxt.koff * 2 : cA; const char* nB = has_next ? (const char*)g.Bt + (size_t)nxt.pn * tstepB + (size_t)nxt.koff * 2 : cB;
        for (int t = 0; t < nt; t += 2) {
            const bool last = (t == nt - 2);
            const char* a1 = cA + (size_t)(t + 1) * kstep;
            const char* a2 = last ? nA : cA + (size_t)(t + 2) * kstep; const char* b2 = last ? nB : cB + (size_t)(t + 2) * kstep;
            const char* a3 = a2 + kstep; const char* b3 = b2 + kstep;
            if (last && has_next) S.a_ready(nxt);
            if constexpr (SP2) {
            PG8_LDB(B0, 0, 0); PG8_LDB(B1, 0, 1); PG8_SCHED; PG8_LDA(At, 0, 0); PG8_STAGE(PG8_SA(1, 1), a1 + hstepA, voffA);
            PG8_WAIT_V(8); PG8_WAIT_L(0); PG8_BAR; PG8_MMA(0, 0, At, B0); PG8_MMA(0, 1, At, B1); PG8_BAR; PG8_SCHED;
            PG8_LDA(At, 0, 1); PG8_STAGE(PG8_SB(0, 0), b2, voffB); PG8_STAGE(PG8_SB(0, 1), b2 + hstepB, voffB); PG8_STAGE(PG8_SA(0, 0), a2, voffA);
            PG8_WAIT_V(8); PG8_WAIT_L(0); PG8_BAR; PG8_MMA(1, 0, At, B0); PG8_MMA(1, 1, At, B1); PG8_BAR; PG8_SCHED;
            PG8_LDB(B0, 1, 0); PG8_LDB(B1, 1, 1); PG8_SCHED; PG8_LDA(At, 1, 0); PG8_STAGE(PG8_SA(0, 1), a2 + hstepA, voffA);
            PG8_WAIT_V(8); PG8_WAIT_L(0); PG8_BAR; PG8_MMA(0, 0, At, B0); PG8_MMA(0, 1, At, B1); PG8_BAR; PG8_SCHED;
            PG8_LDA(At, 1, 1); PG8_STAGE(PG8_SB(1, 0), b3, voffB); PG8_STAGE(PG8_SB(1, 1), b3 + hstepB, voffB); PG8_STAGE(PG8_SA(1, 0), a3, voffA);
            PG8_WAIT_V(8); PG8_WAIT_L(0); PG8_BAR; PG8_MMA(1, 0, At, B0); PG8_MMA(1, 1, At, B1); PG8_BAR; PG8_SCHED;
            } else {
            PG8_LDB(B0, 0, 0); PG8_SCHED; PG8_LDA(At, 0, 0); PG8_STAGE(PG8_SA(1, 1), a1 + hstepA, voffA);
            PG8_WAIT_L(8); PG8_BAR; PG8_WAIT_L(0); PG8_MMA(0, 0, At, B0); PG8_BAR; PG8_SCHED;
            PG8_LDB(B1, 0, 1); PG8_STAGE(PG8_SB(0, 0), b2, voffB);
            PG8_BAR; PG8_WAIT_L(0); PG8_MMA(0, 1, At, B1); PG8_BAR;
            PG8_LDA(At, 0, 1); PG8_STAGE(PG8_SA(0, 0), a2, voffA);
            PG8_BAR; PG8_WAIT_L(0); PG8_MMA(1, 0, At, B0); PG8_BAR; PG8_SCHED;
            PG8_STAGE(PG8_SB(0, 1), b2 + hstepB, voffB);
            PG8_WAIT_V(6); PG8_BAR; PG8_MMA(1, 1, At, B1); PG8_BAR;
            PG8_LDB(B0, 1, 0); PG8_SCHED; PG8_LDA(At, 1, 0); PG8_STAGE(PG8_SA(0, 1), a2 + hstepA, voffA);
            PG8_WAIT_L(8); PG8_BAR; PG8_WAIT_L(0); PG8_MMA(0, 0, At, B0); PG8_BAR; PG8_SCHED;
            PG8_LDB(B1, 1, 1); PG8_STAGE(PG8_SB(1, 0), b3, voffB);
            PG8_BAR; PG8_WAIT_L(0); PG8_MMA(0, 1, At, B1); PG8_BAR;
            PG8_LDA(At, 1, 1); PG8_STAGE(PG8_SA(1, 0), a3, voffA);
            PG8_BAR; PG8_WAIT_L(0); PG8_MMA(1, 0, At, B0); PG8_BAR; PG8_SCHED;
            PG8_STAGE(PG8_SB(1, 1), b3 + hstepB, voffB);
            PG8_WAIT_V(6); PG8_BAR; PG8_MMA(1, 1, At, B1); PG8_BAR;
            }
        }
        if constexpr (ALIGN_EPI) { if (wr == 0) PG8_BAR; }
        if constexpr (!Epi::AFTER_DRAIN) { E(acc, cur, wr, wc, fr, fq); S.done(cur); }
        if (!has_next) break;
#pragma unroll
        for (int a = 0; a < 2; ++a)
#pragma unroll
            for (int b = 0; b < 2; ++b)
#pragma unroll
                for (int m = 0; m < 4; ++m)
#pragma unroll
                    for (int n = 0; n < 2; ++n) acc[a][b][m][n] = (f32x4){0.f, 0.f, 0.f, 0.f};
        cur = nxt; cA = nA; cB = nB; ++ui; if (cur.K) nt = cur.K / BK;
        if constexpr (ALIGN_EPI) { if (wr == 1) PG8_BAR; }
    }
    PG8_WAIT_V(0);
    if constexpr (!ALIGN_EPI) { if (wr == 0) PG8_BAR; }
    PG8_BAR;
    if constexpr (Epi::AFTER_DRAIN) { E.fused(acc, cur, wr, wc, fr, fq, lds, wid, lane); S.done(cur); }
#undef PG8_SA
#undef PG8_SB
#undef PG8_STAGE
#undef PG8_LDA
#undef PG8_LDB
#undef PG8_MMA
#undef PG8_WAIT_V
#undef PG8_WAIT_L
#undef PG8_BAR
#undef PG8_SCHED
}
}

DI void transpose_unit(const float* __restrict__ src, int ldsrc, int n_src0, int n_cnt, int kt, int nt, bf16_t* __restrict__ dst, long dst_ld,
                       int dst_n0, int dst_k0, int mode, unsigned char* smem, int tid512) {
  const int half = tid512 >> 8, tid = tid512 & 255;
  float* T = (float*)(smem + half * 20480);
  float* tab = (float*)(smem + 40960);
  const int k0 = kt * 64, nn0 = nt * 64;
  __syncthreads();
  if (tid512 < 64) tab[tid512] = __builtin_amdgcn_cosf((float)tid512 * (1.f / 64.f)) * 0.125f;
  {
    const int col = tid & 63, rq = tid >> 6;
#pragma unroll
    for (int i = 0; i < 16; ++i) {
      const int k = rq + 4 * i, n = nn0 + col;
      T[k * 65 + col] = (n < n_cnt) ? src[(long)(k0 + k) * ldsrc + n_src0 + n] : 0.f;
    }
  }
  __syncthreads();
  const int n = tid >> 2, q = tid & 3;
  float v[16];
  if (mode == 0) {
#pragma unroll
    for (int j = 0; j < 16; ++j) v[j] = T[(q * 16 + j) * 65 + n];
  } else {
#pragma unroll
    for (int j = 0; j < 16; ++j) v[j] = 0.f;
    const int sh = mode == 2 ? 48 : 0;
    for (int c = 0; c < 64; ++c) {
      const float w = tab[(c * n + sh) & 63];
#pragma unroll
      for (int j = 0; j < 16; ++j) v[j] += T[(q * 16 + j) * 65 + c] * w;
    }
  }
  if (nn0 + n < n_cnt) {
    u32x4 o0, o1;
    o0.x = pk_bf16(v[0], v[1]); o0.y = pk_bf16(v[2], v[3]); o0.z = pk_bf16(v[4], v[5]); o0.w = pk_bf16(v[6], v[7]);
    o1.x = pk_bf16(v[8], v[9]); o1.y = pk_bf16(v[10], v[11]); o1.z = pk_bf16(v[12], v[13]); o1.w = pk_bf16(v[14], v[15]);
    bf16_t* d = dst + (long)(dst_n0 + nn0 + n) * dst_ld + dst_k0 + k0 + q * 16;
    *(u32x4*)d = o0;
    *(u32x4*)(d + 8) = o1;
  }
}

DI void phase_prep_a(const Params& p, unsigned char* smem) {
  bf16_t* WinT = (bf16_t*)(p.ws + OFF_WINT);
  bf16_t* WgT = (bf16_t*)(p.ws + OFF_WGT);
  float* MODP = (float*)(p.ws + OFF_MODP);
  const int tid = hide_tid();
  const int half = tid >> 8;
  if (blockIdx.x == 0 && tid < 64) ((unsigned*)(p.ws + OFF_CTR))[tid] = 0u;
  const int N_MOD = 192, N_WIN = 2 * 16 * 14, N_WG = 2 * 16 * 24, N_FOLD = 2 * 16 * 4, N_ZERO = 2 * 96 * 128 / NTHR;
  const int total = N_MOD + N_WIN + N_WG + N_FOLD + N_ZERO;
  for (int u0 = blockIdx.x; u0 < total; u0 += gridDim.x) {
    int u = u0;
    if (u < N_MOD) {
      const int l = u / 96, rem = u % 96, cc = rem / 16, kc = rem % 16;
      float* s = (float*)smem;
      __syncthreads();
      if (tid < 192) {
        const int v = tid >> 6, k = tid & 63;
        const float cv = v == 0 ? p.c_ctx[kc * 64 + k] : p.c[(v - 1) * 1024 + kc * 64 + k];
        s[tid] = silu_f(cv);
      }
      __syncthreads();
      const int col = cc * 512 + tid;
      const float* w = p.w_mod + ((long)l * 1024 + kc * 64) * 3072 + col;
      float a0 = 0.f, a1 = 0.f, a2 = 0.f;
#pragma unroll 16
      for (int k = 0; k < 64; ++k) {
        const float wv = w[(long)k * 3072];
        a0 += s[k] * wv; a1 += s[64 + k] * wv; a2 += s[128 + k] * wv;
      }
      float* o = MODP + ((long)(kc * 2 + l) * 3) * 3072 + col;
      o[0] = a0; o[3072] = a1; o[6144] = a2;
      continue;
    }
    u -= N_MOD;
    if (u < N_WIN) {
      const int l = u / 224, rem = u % 224, kt = rem / 14, nt = 2 * (rem % 14) + half;
      transpose_unit(p.w_in + (long)l * 1024 * 5024, 5024, 256, 1696, kt, nt, WinT + (long)l * NEXTP * LDX, LDX, 512, 0, 0, smem, tid);
      continue;
    }
    u -= N_WIN;
    if (u < N_WG) {
      const int l = u / 384, rem = u % 384, kt = rem / 24, nt = 2 * (rem % 24) + half;
      transpose_unit(p.w_in + (long)l * 1024 * 5024, 5024, 1952, 3072, kt, nt, WgT + (long)l * 3072 * LDX, LDX, 0, 0, 0, smem, tid);
      continue;
    }
    u -= N_WG;
    if (u < N_FOLD) {
      const int l = u / 64, rem = u % 64, kt = rem / 4, g = rem & 3, part = half;
      transpose_unit(p.w_in + (long)l * 1024 * 5024, 5024, g * 64, 64, kt, 0, WinT + (long)l * NEXTP * LDX, LDX, part * 256 + g * 64, 0, 1 + part, smem, tid);
      continue;
    }
    u -= N_FOLD;
    {
      const long id = (long)u * NTHR + tid;
      const int l = (int)(id / (96 * 128)), rem = (int)(id % (96 * 128));
      u32x4 z = {0u, 0u, 0u, 0u};
      *(u32x4*)(WinT + (long)l * NEXTP * LDX + (long)(NEXT + rem / 128) * LDX + (long)(rem % 128) * 8) = z;
    }
  }
}

DI void phase_prep_b(const Params& p, unsigned char* smem) {
  const int tid = hide_tid();
  const int half = tid >> 8;
  float* tab = (float*)(smem + 65536);
  for (int i = tid; i < 4096; i += NTHR) tab[i] = __builtin_amdgcn_cosf((float)i * (1.f / 4096.f));
  __syncthreads();
  bf16_t* WqT = (bf16_t*)(p.ws + OFF_WQT);
  bf16_t* WkvT = (bf16_t*)(p.ws + OFF_WKVT);
  bf16_t* WbrT = (bf16_t*)(p.ws + OFF_WBRT);
  bf16_t* WoutT = (bf16_t*)(p.ws + OFF_WOUTT);
  bf16_t* PoolWt = (bf16_t*)(p.ws + OFF_POOLWT);
  const float* MODP = (const float*)(p.ws + OFF_MODP);
  float* MODF = (float*)(p.ws + OFF_MODF);
  float* ROPE = (float*)(p.ws + OFF_ROPE);
  bf16_t* Dp = (bf16_t*)(p.ws + OFF_DP);
  bf16_t* A1 = (bf16_t*)(p.ws + OFF_A1);
  bf16_t* D2 = (bf16_t*)(p.ws + OFF_D2);
  const int N_MODF = 36, N_WQ = 48, N_WKV = 32, N_BRA = 64, N_BRB = 64, N_BRC = 128, N_WOUT = 256, N_POOL = 256, N_ROPE = 256, N_DP = 32, N_A1 = 16, N_D2 = 512;
  const int total = N_MODF + N_WQ + N_WKV + N_BRA + N_BRB + N_BRC + N_WOUT + N_POOL + N_ROPE + N_DP + N_A1 + N_D2;
  for (int u0 = blockIdx.x; u0 < total; u0 += gridDim.x) {
    int u = u0;
    if (u < N_MODF) {
      const int idx = u * NTHR + tid;
      const int l = idx / 9216, rem = idx % 9216, col = rem % 3072;
      float a = p.b_mod[l * 3072 + col];
      for (int kc = 0; kc < 16; ++kc) a += MODP[(long)kc * 18432 + l * 9216 + rem];
      MODF[idx] = a;
      continue;
    }
    u -= N_MODF;
    if (u < N_WQ) { const int l = u / 24, rem = u % 24; transpose_unit(p.w_q_up + (long)l * 256 * 768, 768, 0, 768, rem / 6, 2 * (rem % 6) + half, WqT + (long)l * 768 * 256, 256, 0, 0, 0, smem, tid); continue; }
    u -= N_WQ;
    if (u < N_WKV) { const int l = u / 16, rem = u % 16; transpose_unit(p.w_kv_up + (long)l * 128 * 1024, 1024, 0, 1024, rem / 8, 2 * (rem % 8) + half, WkvT + (long)l * 1024 * 128, 128, 0, 0, 0, smem, tid); continue; }
    u -= N_WKV;
    if (u < N_BRA) { const int l = u / 32, rem = u % 32; transpose_unit(p.w_br_a + (long)l * 256 * 1024, 1024, 0, 1024, rem / 8, 2 * (rem % 8) + half, WbrT + (long)l * 1024 * 1024, 1024, 0, 0, 0, smem, tid); continue; }
    u -= N_BRA;
    if (u < N_BRB) { const int l = u / 32, rem = u % 32; transpose_unit(p.w_br_b + (long)l * 256 * 1024, 1024, 0, 1024, rem / 8, 2 * (rem % 8) + half, WbrT + (long)l * 1024 * 1024, 1024, 0, 256, 0, smem, tid); continue; }
    u -= N_BRB;
    if (u < N_BRC) { const int l = u / 64, rem = u % 64; transpose_unit(p.w_br_c + (long)l * 512 * 1024, 1024, 0, 1024, rem / 8, 2 * (rem % 8) + half, WbrT + (long)l * 1024 * 1024, 1024, 0, 512, 0, smem, tid); continue; }
    u -= N_BRC;
    if (u < N_WOUT) { const int l = u / 128, rem = u % 128; transpose_unit(p.w_out + (long)l * 1024 * 1024, 1024, 0, 1024, rem / 8, 2 * (rem % 8) + half, WoutT + (long)l * 1024 * 1024, 1024, 0, 0, 0, smem, tid); continue; }
    u -= N_WOUT;
    if (u < N_POOL) {
      const int idx = u * NTHR + tid;
      const int l = idx >> 16, n = (idx >> 8) & 255, k = idx & 255;
      float v = 0.f;
      if ((n >> 6) == (k >> 6)) v = p.pool_w[(((long)l * 4 + (n >> 6)) * 64 + (k & 63)) * 64 + (n & 63)];
      PoolWt[idx] = f2bf(v);
      continue;
    }
    u -= N_POOL;
    if (u < N_ROPE) {
      const int idx = u * NTHR + tid;
      const int pos = idx >> 5, d = idx & 31, f = d & 7;
      const float base = d < 16 ? (float)(pos >> 6) : (float)(pos & 63);
      const float freq = exp2f(-(float)f * (13.287712379549449f / 8.f));
      float rev = base * freq * 0.15915494309189535f;
      rev -= floorf(rev);
      ROPE[idx] = __builtin_amdgcn_cosf(rev);
      ROPE[4096 * 32 + idx] = __builtin_amdgcn_sinf(rev);
      continue;
    }
    u -= N_ROPE;
    if (u < N_DP) {
      const int id = u * NTHR + tid;
      const int lr = id >> 6, k0 = (id & 63) * 8, part = k0 >= 256, l0 = k0 & 255;
      float v[8];
#pragma unroll
      for (int j = 0; j < 8; ++j) { int n = ((lr * (l0 + j)) & 255) * 16; if (part) n = (n + 1024) & 4095; v[j] = tab[n] * (1.f / 16.f); }
      u32x4 o; o.x = pk_bf16(v[0], v[1]); o.y = pk_bf16(v[2], v[3]); o.z = pk_bf16(v[4], v[5]); o.w = pk_bf16(v[6], v[7]);
      *(u32x4*)(Dp + (long)lr * 512 + k0) = o;
      continue;
    }
    u -= N_DP;
    if (u < N_A1) {
      const int id = u * NTHR + tid;
      const int m = id >> 5, k0 = (id & 31) * 8, pm = (m >> 6) & 1, l1p = m & 63;
      float v[8];
#pragma unroll
      for (int j = 0; j < 8; ++j) {
        const int k = k0 + j, pk = (k >> 6) & 1, l1 = k & 63;
        float val = 0.f;
        if ((k >> 7) == (m >> 7)) {
          int n = ((l1 * l1p) & 63) * 64;
          if (pm != pk) n = (n + (pm == 0 ? 1024 : 3072)) & 4095;
          val = tab[n] * 0.125f;
        }
        v[j] = val;
      }
      u32x4 o; o.x = pk_bf16(v[0], v[1]); o.y = pk_bf16(v[2], v[3]); o.z = pk_bf16(v[4], v[5]); o.w = pk_bf16(v[6], v[7]);
      *(u32x4*)(A1 + (long)m * 256 + k0) = o;
      continue;
    }
    u -= N_A1;
    {
      const int id = u * NTHR + tid;
      const int row = id >> 6, k0 = (id & 63) * 8, qd = row >> 8, m = row & 255;
      const int lp = (4 * qd + (m >> 6)) + 64 * (m & 63);
      float v[8];
#pragma unroll
      for (int e = 0; e < 8; ++e) {
        const int k = k0 + e, blk = k >> 7, part = (k >> 6) & 1, l2 = k & 63;
        float val = 0.f;
        if (blk == (m >> 6)) {
          int n = (l2 * lp) & 4095;
          if (part) n = (n + 1024) & 4095;
          val = tab[n] * 0.125f;
        }
        v[e] = val;
      }
      u32x4 o; o.x = pk_bf16(v[0], v[1]); o.y = pk_bf16(v[2], v[3]); o.z = pk_bf16(v[4], v[5]); o.w = pk_bf16(v[6], v[7]);
      *(u32x4*)(D2 + (long)row * 512 + k0) = o;
    }
  }
}

DI void phase_xn(const Params& p, int l) {
  const int tid = hide_tid();
  const int wave = tid >> 6, lane = tid & 63;
  const float* ng = p.norm_g + l * 1024;
  const float* MODF = (const float*)(p.ws + OFF_MODF) + l * 9216;
  bf16_t* XN = (bf16_t*)(p.ws + OFF_XN);
  for (int row = blockIdx.x * NWAVE + wave; row < NTOK; row += gridDim.x * NWAVE) {
    const float* src = row < NPT ? p.x_prompt + (long)row * 1024 : p.x_sample + (long)(row - NPT) * 1024;
    const bf16_t* srcb = (const bf16_t*)p.out + (long)row * 1024;
    const float* md = MODF + tok_mod_idx(row) * 3072;
    f32x4 x[4];
    float ss = 0.f;
#pragma unroll
    for (int j = 0; j < 4; ++j) {
      if (l == 0) x[j] = *(const f32x4*)(src + j * 256 + lane * 4);
      else { const u32x2 hw = *(const u32x2*)(srcb + j * 256 + lane * 4); x[j] = (f32x4){bf_lo(hw.x), bf_hi(hw.x), bf_lo(hw.y), bf_hi(hw.y)}; }
      ss += x[j][0] * x[j][0] + x[j][1] * x[j][1] + x[j][2] * x[j][2] + x[j][3] * x[j][3];
    }
    ss = wave_sum(ss);
    const float r = rsqrtf(ss * (1.f / 1024.f) + EPS);
#pragma unroll
    for (int j = 0; j < 4; ++j) {
      const int c = j * 256 + lane * 4;
      const f32x4 g = *(const f32x4*)(ng + c), sh = *(const f32x4*)(md + c), sc = *(const f32x4*)(md + 1024 + c);
      float o[4];
#pragma unroll
      for (int e = 0; e < 4; ++e) o[e] = (x[j][e] * r) * g[e] * (1.f + sc[e]) + sh[e];
      u32x2 w; w.x = pk_bf16(o[0], o[1]); w.y = pk_bf16(o[2], o[3]);
      *(u32x2*)(XN + (long)row * LDX + c) = w;
    }
  }
}

struct EpiWin {
  static constexpr bool PERM = true, AFTER_DRAIN = false;
  bf16_t* P; float* LAT; bf16_t* ATp; bf16_t* Z;
  DI void operator()(const pg8::f32x4 (&acc)[2][2][4][2], const pg8::Unit& u, int wr, int wc, int fr_, int fq_) const {
    int fr = fr_, fq = fq_;
    asm volatile("" : "+v"(fr), "+v"(fq));
#pragma unroll
    for (int bj = 0; bj < 2; ++bj) {
      const int cb = u.pn * 256 + bj * 128 + wc * 32, c0 = cb + 8 * fq;
#pragma unroll
      for (int ai = 0; ai < 2; ++ai)
#pragma unroll
        for (int m = 0; m < 4; ++m) {
          const int row = u.pm * 256 + ai * 128 + wr * 64 + m * 16 + fr;
          const pg8::f32x4 v0 = acc[ai][bj][m][0], v1 = acc[ai][bj][m][1];
          if (cb < 512) {
            const int part = cb >> 8, cc = c0 & 255;
            bf16_t* dst;
            long cst;
            if (row < NPT) { const int b = row >> 8, pos = row & 255; dst = ATp + ((long)b * 256 + cc) * 512 + part * 256 + pos; cst = 512; }
            else { const int rs = row - NPT, b = rs >> 12, pos = rs & 4095; dst = Z + (((long)b * 256 + cc) * 2 + part) * 4096 + pos; cst = 8192; }
#pragma unroll
            for (int e = 0; e < 4; ++e) { dst[(long)e * cst] = f2bf(v0[e]); dst[(long)(4 + e) * cst] = f2bf(v1[e]); }
          } else if (cb >= 1280 && cb < 1696) {
            float* d = LAT + (long)row * LATW + (c0 - 1280);
            *(f32x4*)d = v0; *(f32x4*)(d + 4) = v1;
          } else if (cb < NEXT) {
            const bool raw = (cb >= 768 && cb < 1024);
            const int pc = c0 < 1280 ? c0 - 512 : c0 - 928;
            float o[8];
#pragma unroll
            for (int e = 0; e < 4; ++e) { o[e] = raw ? v0[e] : silu_f(v0[e]); o[4 + e] = raw ? v1[e] : silu_f(v1[e]); }
            u32x4 w; w.x = pk_bf16(o[0], o[1]); w.y = pk_bf16(o[2], o[3]); w.z = pk_bf16(o[4], o[5]); w.w = pk_bf16(o[6], o[7]);
            *(u32x4*)(P + (long)row * PW + pc) = w;
          }
        }
    }
  }
};
DI void phase_win(const Params& p, int l, unsigned char* smem) {
  pg8::Gemm g{(const bf16_t*)(p.ws + OFF_XN), (const bf16_t*)(p.ws + OFF_WINT) + (long)l * NEXTP * LDX, NTOK, 2048, 1024, LDX, LDX};
  pg8::StaticOrder S;
  S.init(NTOK, 2048, gridDim.x, blockIdx.x);
  EpiWin E{(bf16_t*)(p.ws + OFF_P), (float*)(p.ws + OFF_LAT), (bf16_t*)(p.ws + OFF_ATP), (bf16_t*)(p.ws + OFF_Z)};
  __syncthreads();
  pg8::gemm_phase<EpiWin, pg8::StaticOrder, true, true>((PG8_LAS unsigned char*)smem, g, S, E);
}

struct TailOrder {
  int c, nwb;
  DI bool next(int i, pg8::Unit& u) const { const int L = i * nwb + c; if (L >= 64) return false; u.pm = L; u.pn = 8; return true; }
  DI void a_ready(const pg8::Unit&) const {}
  DI void done(const pg8::Unit&) const {}
};
DI void phase_win_tail(const Params& p, int l, unsigned char* smem, int nwb) {
  pg8::Gemm g{(const bf16_t*)(p.ws + OFF_XN), (const bf16_t*)(p.ws + OFF_WINT) + (long)l * NEXTP * LDX, NTOK, NEXTP, 1024, LDX, LDX};
  TailOrder S{(int)blockIdx.x, nwb};
  EpiWin E{(bf16_t*)(p.ws + OFF_P), (float*)(p.ws + OFF_LAT), (bf16_t*)(p.ws + OFF_ATP), (bf16_t*)(p.ws + OFF_Z)};
  __syncthreads();
  pg8::gemm_phase<EpiWin, TailOrder, true, true>((PG8_LAS unsigned char*)smem, g, S, E);
}

DI void phase_lat(const Params& p, int l, int first, int stride) {
  const int tid = hide_tid();
  const int wave = tid >> 6, lane = tid & 63;
  const float* LAT = (const float*)(p.ws + OFF_LAT);
  const float* ROPE = (const float*)(p.ws + OFF_ROPE);
  bf16_t* QN = (bf16_t*)(p.ws + OFF_QN);
  bf16_t* CKVB = (bf16_t*)(p.ws + OFF_CKVB);
  bf16_t* KR = (bf16_t*)(p.ws + OFF_KR);
  const float* qg = p.q_norm_g + l * 256;
  const float* kg = p.kv_norm_g + l * 128;
  constexpr int R = 4;
  const int rstep = stride * NWAVE;
  for (int row0 = first * NWAVE + wave; row0 < NROWS_KV; row0 += rstep * R) {
    f32x4 q[R]; f32x2 kv[R]; float kr[R], cs[R], sn[R];
#pragma unroll
    for (int i = 0; i < R; ++i) {
      const int row = min(row0 + i * rstep, NROWS_KV - 1);
      q[i] = (f32x4){0.f, 0.f, 0.f, 0.f}; cs[i] = 0.f; sn[i] = 0.f;
      if (row < NTOK) {
        const float* src = LAT + (long)row * LATW;
        q[i] = *(const f32x4*)(src + lane * 4);
        kv[i] = *(const f32x2*)(src + 256 + lane * 2);
        kr[i] = lane < 32 ? src[384 + lane] : 0.f;
        if (row >= NPT && lane < 32) { const int pos = (row - NPT) & 4095; cs[i] = ROPE[pos * 32 + lane]; sn[i] = ROPE[4096 * 32 + pos * 32 + lane]; }
      } else {
        const int cr = row - NTOK, b = cr >> 9, pp = cr & 511;
        kv[i] = *(const f32x2*)(p.cache_ckv + ((long)(b * 2 + l) * 512 + pp) * 128 + lane * 2);
        kr[i] = lane < 32 ? p.cache_krope[((long)(b * 2 + l) * 512 + pp) * 32 + lane] : 0.f;
      }
    }
    const f32x4 g = *(const f32x4*)(qg + lane * 4);
    const f32x2 g2 = *(const f32x2*)(kg + lane * 2);
#pragma unroll
    for (int i = 0; i < R; ++i) {
      const int row = row0 + i * rstep;
      if (row >= NROWS_KV) break;
      if (row < NTOK) {
        float ssq = wave_sum(q[i][0] * q[i][0] + q[i][1] * q[i][1] + q[i][2] * q[i][2] + q[i][3] * q[i][3]);
        float ssk = wave_sum(kv[i][0] * kv[i][0] + kv[i][1] * kv[i][1]);
        const float rq = rsqrtf(ssq * (1.f / 256.f) + EPS), rk = rsqrtf(ssk * (1.f / 128.f) + EPS);
        u32x2 w; w.x = pk_bf16(q[i][0] * rq * g[0], q[i][1] * rq * g[1]); w.y = pk_bf16(q[i][2] * rq * g[2], q[i][3] * rq * g[3]);
        *(u32x2*)(QN + (long)row * 256 + lane * 4) = w;
        const float c0 = kv[i][0] * rk * g2[0], c1 = kv[i][1] * rk * g2[1];
        *(unsigned*)(CKVB + (long)row * 128 + lane * 2) = pk_bf16(c0, c1);
        if (row < NPT) {
          const int b = row >> 8, s = row & 255;
          const long o = ((long)(b * 2 + l) * 256 + s);
          f32x2 cv = {c0, c1};
          *(f32x2*)(p.out + OUT_CKV + o * 128 + lane * 2) = cv;
          if (lane < 32) {
            p.out[OUT_KR + o * 32 + lane] = kr[i];
            KR[(long)row * 32 + lane] = f2bf(kr[i]);
          }
        } else {
          const int rs = row - NPT, b = rs >> 12, pos = rs & 4095;
          const float partner = __shfl_xor(kr[i], 8);
          if (lane < 32) {
            const float rx = (lane & 8) ? partner : -partner;
            KR[((long)NPT + (long)b * LKS + pos) * 32 + lane] = f2bf(kr[i] * cs[i] + rx * sn[i]);
          }
        }
      } else {
        const int cr = row - NTOK, b = cr >> 9, pp = cr & 511;
        *(unsigned*)(CKVB + (long)row * 128 + lane * 2) = pk_bf16(kv[i][0], kv[i][1]);
        if (lane < 32) KR[((long)NPT + (long)b * LKS + 4096 + pp) * 32 + lane] = f2bf(kr[i]);
      }
    }
  }
}

template <int W> DI void pool_item(const bf16_t* __restrict__ P, bf16_t* __restrict__ PB, int t, int ch) {
  constexpr int left = W / 2, right = W - 1 - left;
  int s0, L;
  if (t < NPT) { s0 = t & ~255; L = 256; } else { s0 = NPT + ((t - NPT) & ~4095); L = 4096; }
  const int tt = t - s0;
  u32x4 v[W];
#pragma unroll
  for (int j = 0; j < W; ++j) {
    int idx = tt - left + j;
    idx = idx < 0 ? 0 : (idx > L - 1 ? L - 1 : idx);
    v[j] = *(const u32x4*)(P + (long)(s0 + idx) * PW + PC_BIN + ch * 8);
  }
  float sum[8];
#pragma unroll
  for (int e = 0; e < 8; ++e) sum[e] = 0.f;
#pragma unroll
  for (int j = 0; j < W; ++j) {
    const int idx = tt - left + j;
    const float m = (idx >= 0 && idx < L) ? 1.f : 0.f;
    sum[0] += m * bf_lo(v[j].x); sum[1] += m * bf_hi(v[j].x); sum[2] += m * bf_lo(v[j].y); sum[3] += m * bf_hi(v[j].y);
    sum[4] += m * bf_lo(v[j].z); sum[5] += m * bf_hi(v[j].z); sum[6] += m * bf_lo(v[j].w); sum[7] += m * bf_hi(v[j].w);
  }
  const int lo = max(tt - left, 0), hi = min(tt + right, L - 1);
  const u32x4 c = v[left];
  const float inv = 1.f / (float)(hi - lo + 1);
  u32x4 o;
  o.x = pk_bf16(sum[0] * inv - bf_lo(c.x), sum[1] * inv - bf_hi(c.x));
  o.y = pk_bf16(sum[2] * inv - bf_lo(c.y), sum[3] * inv - bf_hi(c.y));
  o.z = pk_bf16(sum[4] * inv - bf_lo(c.z), sum[5] * inv - bf_hi(c.z));
  o.w = pk_bf16(sum[6] * inv - bf_lo(c.w), sum[7] * inv - bf_hi(c.w));
  *(u32x4*)(PB + (long)t * 256 + ch * 8) = o;
}
DI void phase_up(const Params& p, int l, unsigned char* smem) {
  const int tid_outer = hide_tid();
  const bf16_t* QN = (const bf16_t*)(p.ws + OFF_QN);
  const bf16_t* CKVB = (const bf16_t*)(p.ws + OFF_CKVB);
  const bf16_t* WqT = (const bf16_t*)(p.ws + OFF_WQT) + (long)l * 768 * 256;
  const bf16_t* WkvT = (const bf16_t*)(p.ws + OFF_WKVT) + (long)l * 1024 * 128;
  const float* ROPE = (const float*)(p.ws + OFF_ROPE);
  bf16_t* Q = (bf16_t*)(p.ws + OFF_Q);
  bf16_t* Kp = (bf16_t*)(p.ws + OFF_KP);
  bf16_t* Ks = (bf16_t*)(p.ws + OFF_KS);
  bf16_t* Vtp = (bf16_t*)(p.ws + OFF_VTP);
  bf16_t* Vts = (bf16_t*)(p.ws + OFF_VTS);
  const bf16_t* P = (const bf16_t*)(p.ws + OFF_P);
  bf16_t* PB = (bf16_t*)(p.ws + OFF_PB);
  const int N_Q = 64 * 3, N_KV = 68 * 4;
  const int total = N_Q + N_KV;
  const int tid0 = tid_outer;
  for (int u0 = virt_block(); u0 < total; u0 += gridDim.x) {
    int tid = tid0;
    asm volatile("" : "+v"(tid));
    int u = u0;
    if (u < N_Q) {
      int mt, nt;
      tile_decode(u, 3, mt, nt);
      f32x16 acc[4][2];
      acc_zero(acc);
      gemm_main(tid, QN + (long)mt * 256 * 256, 256, WqT + (long)nt * 256 * 256, 256, 256, acc, smem);
      epi_blocks(tid, acc, mt * 256, nt * 256, [&](int row, int cb, int hh, const f32x16& a) {
        const int head = cb / 96, j0 = cb % 96;
        bf16_t* d;
        int pos = 0;
        const bool samp = row >= NPT;
        if (!samp) { const int b = row >> 8; pos = row & 255; d = Q + ((long)(b * 8 + head) * 256 + pos) * 96 + j0 + 4 * hh; }
        else { const int rs = row - NPT, b = rs >> 12; pos = rs & 4095; d = Q + (long)NPT * 768 + ((long)(b * 8 + head) * 4096 + pos) * 96 + j0 + 4 * hh; }
        float v[16];
#pragma unroll
        for (int i = 0; i < 16; ++i) v[i] = a[i];
        if (samp && j0 == 64) {
#pragma unroll
          for (int gp = 0; gp < 2; ++gp) {
            const f32x4 cs = *(const f32x4*)(ROPE + pos * 32 + 16 * gp + 4 * hh);
            const f32x4 sn = *(const f32x4*)(ROPE + 4096 * 32 + pos * 32 + 16 * gp + 4 * hh);
#pragma unroll
            for (int e = 0; e < 4; ++e) {
              const float x0 = a[8 * gp + e], x1 = a[8 * gp + 4 + e];
              v[8 * gp + e] = x0 * cs[e] - x1 * sn[e];
              v[8 * gp + 4 + e] = x1 * cs[e] + x0 * sn[e];
            }
          }
        }
#pragma unroll
        for (int g = 0; g < 4; ++g) {
          u32x2 w; w.x = pk_bf16(v[4 * g] * QSCALE, v[4 * g + 1] * QSCALE); w.y = pk_bf16(v[4 * g + 2] * QSCALE, v[4 * g + 3] * QSCALE);
          *(u32x2*)(d + 8 * g) = w;
        }
      });
      continue;
    }
    u -= N_Q;
    if (u < N_KV) {
      const int mt = u >> 2, nt = u & 3;
      f32x16 acc[4][2];
      acc_zero(acc);
      gemm_main(tid, CKVB + (long)mt * 256 * 128, 128, WkvT + (long)nt * 256 * 128, 128, 128, acc, smem);
      epi_blocks(tid, acc, mt * 256, nt * 256, [&](int row, int cb, int hh, const f32x16& a) {
        const int head = cb >> 7, j0 = cb & 127;
        const bool samp = row >= NPT;
        int b, pos;
        if (!samp) { b = row >> 8; pos = row & 255; }
        else if (row < NTOK) { const int rs = row - NPT; b = rs >> 12; pos = rs & 4095; }
        else { const int cr = row - NTOK; b = cr >> 9; pos = 4096 + (cr & 511); }
        const int Lk = samp ? LKS : 256;
        const size_t kofs = samp ? OFF_KS : OFF_KP, vofs = samp ? OFF_VTS : OFF_VTP;
        bf16_t* kbase = (bf16_t*)(p.ws + kofs) + (long)(b * 8 + head) * Lk * 64;
        bf16_t* vbase = (bf16_t*)(p.ws + vofs) + (long)(b * 8 + head) * 64 * Lk;
        if (j0 < 64) {
          bf16_t* d = kbase + (long)pos * 64 + j0 + 4 * hh;
#pragma unroll
          for (int g = 0; g < 4; ++g) { u32x2 w; w.x = pk_bf16(a[4 * g], a[4 * g + 1]); w.y = pk_bf16(a[4 * g + 2], a[4 * g + 3]); *(u32x2*)(d + 8 * g) = w; }
        } else {
          bf16_t* d = vbase + (long)(j0 - 64 + 4 * hh) * Lk + pos;
#pragma unroll
          for (int i = 0; i < 16; ++i) d[(long)((i & 3) + 8 * (i >> 2)) * Lk] = f2bf(a[i]);
        }
      });
      continue;
    }
  }
}

DI void phase_aux(const Params& p, int l, unsigned char* smem, int first, int stride) {
  const int tid_outer = hide_tid();
  const bf16_t* P = (const bf16_t*)(p.ws + OFF_P);
  bf16_t* PB = (bf16_t*)(p.ws + OFF_PB);
  const int N_F1 = 128, N_POOL = 1024;
  const int total = N_F1 + N_POOL;
  const int tid0 = tid_outer;
  for (int u0 = first; u0 < total; u0 += stride) {
    int tid = tid0;
    asm volatile("" : "+v"(tid));
    int u = u0;
    if (u < N_F1) {
      const int b = u >> 6, cg = u & 63;
      const bf16_t* A1 = (const bf16_t*)(p.ws + OFF_A1);
      const bf16_t* Zs = (const bf16_t*)(p.ws + OFF_Z) + ((long)(b * 256 + 4 * cg) * 2) * 4096;
      bf16_t* Y1 = (bf16_t*)(p.ws + OFF_Y1) + ((long)(b * 256 + 4 * cg) * 64) * 128;
      f32x16 acc[4][2];
      acc_zero(acc);
      __syncthreads();
      gemm_dma_b(tid, A1, 256, 0, smem);
      gemm_dma_b(tid, A1, 256, 64, smem + GM_STAGE);
#pragma unroll
      for (int part = 0; part < 2; ++part)
#pragma unroll
        for (int it = 0; it < 4; ++it) {
          const int item = tid + NTHR * it, l2c = item & 7, l1 = (item >> 3) & 63, cl = item >> 9;
          const u32x4 v = *(const u32x4*)(Zs + ((long)(cl * 2 + part)) * 4096 + l1 * 64 + l2c * 8);
          const unsigned w[4] = {v.x, v.y, v.z, v.w};
          unsigned char* st = smem + part * GM_STAGE;
#pragma unroll
          for (int e = 0; e < 8; ++e) {
            const int m = cl * 64 + l2c * 8 + e;
            const unsigned hv = (e & 1) ? (w[e >> 1] >> 16) : (w[e >> 1] & 0xffffu);
            *(bf16_t*)(st + m * 128 + (((l1 >> 3) ^ ((m >> 1) & 7)) << 4) + (l1 & 7) * 2) = (bf16_t)hv;
          }
        }
      asm volatile("s_waitcnt vmcnt(0)" ::: "memory");
      __syncthreads();
      gemm_compute(tid, smem, acc);
      gemm_compute(tid, smem + GM_STAGE, acc);
      __syncthreads();
      epi_blocks(tid, acc, 0, 0, [&](int row, int cb, int hh, const f32x16& a) {
        if (cb < 128) {
          bf16_t* d = Y1 + ((long)(row >> 6) * 64) * 128 + (row & 63);
#pragma unroll
          for (int i = 0; i < 16; ++i) { const int n = cb + (i & 3) + 8 * (i >> 2) + 4 * hh; d[(long)(n & 63) * 128 + (n >> 6) * 64] = f2bf(a[i]); }
        }
      });
      continue;
    }
    u -= N_F1;
    {
      const int id = u * NTHR + tid;
      const int gi = (id >> 6) & 3, t = ((id >> 8) << 3) | ((id >> 3) & 7), ch = gi * 8 + (id & 7);
      if (gi == 0) pool_item<2>(P, PB, t, ch);
      else if (gi == 1) pool_item<4>(P, PB, t, ch);
      else if (gi == 2) pool_item<8>(P, PB, t, ch);
      else pool_item<16>(P, PB, t, ch);
    }
  }
}

constexpr int ATT_KSTR = 208, ATT_VSTR = 144, ATT_VOFF = 64 * ATT_KSTR, ATT_STAGE = ATT_VOFF + 64 * ATT_VSTR;
DI void attn_load_g(int tid, const bf16_t* __restrict__ Kn, const bf16_t* __restrict__ Kr, const bf16_t* __restrict__ Vt, int Lk, int kt, u32x4 (&rk)[2], u32x4& rv) {
  rk[0] = *(const u32x4*)(Kn + (long)kt * 64 * 64 + (long)tid * 8);
  if (tid < 256) rk[1] = *(const u32x4*)(Kr + (long)kt * 64 * 32 + (long)tid * 8);
  { const int dv = tid >> 3, part = tid & 7; rv = *(const u32x4*)(Vt + (long)dv * Lk + kt * 64 + part * 8); }
}
DI void attn_store_l(int tid, unsigned char* st, const u32x4 (&rk)[2], const u32x4& rv) {
  { const int key = tid >> 3, part = tid & 7; *(u32x4*)(st + key * ATT_KSTR + part * 16) = rk[0]; }
  if (tid < 256) { const int key = tid >> 2, part = 8 + (tid & 3); *(u32x4*)(st + key * ATT_KSTR + part * 16) = rk[1]; }
  {
    const int dv = tid >> 3, part = tid & 7;
    unsigned char* d = st + ATT_VOFF + dv * ATT_VSTR + ((part >> 1) * 16 + (part & 1) * 4) * 2;
    u32x2 lo = {rv.x, rv.y}, hi = {rv.z, rv.w};
    *(u32x2*)d = lo;
    *(u32x2*)(d + 16) = hi;
  }
}
DI void attn_unit(const Params& p, int kind, int idx, unsigned char* smem, int tid) {
  int Lq, Lk, b, h, qb, tokbase;
  const bf16_t *Q, *Kn, *Kr, *Vt;
  if (kind) {
    Lq = 4096; Lk = LKS; qb = idx & 15; h = (idx >> 4) & 7; b = idx >> 7; tokbase = NPT + b * 4096;
    Q = (const bf16_t*)(p.ws + OFF_Q) + (long)NPT * 768 + ((long)(b * 8 + h) * Lq + qb * 256) * 96;
    Kn = (const bf16_t*)(p.ws + OFF_KS) + (long)(b * 8 + h) * Lk * 64;
    Kr = (const bf16_t*)(p.ws + OFF_KR) + ((long)NPT + (long)b * LKS) * 32;
    Vt = (const bf16_t*)(p.ws + OFF_VTS) + (long)(b * 8 + h) * 64 * Lk;
  } else {
    Lq = 256; Lk = 256; qb = 0; h = idx & 7; b = idx >> 3; tokbase = b * 256;
    Q = (const bf16_t*)(p.ws + OFF_Q) + ((long)(b * 8 + h) * Lq) * 96;
    Kn = (const bf16_t*)(p.ws + OFF_KP) + (long)(b * 8 + h) * Lk * 64;
    Kr = (const bf16_t*)(p.ws + OFF_KR) + (long)b * 256 * 32;
    Vt = (const bf16_t*)(p.ws + OFF_VTP) + (long)(b * 8 + h) * 64 * Lk;
  }
  const int wave = tid >> 6, lane = tid & 63, r = lane & 31, hh = lane >> 5;
  bf16x8 qf[6];
#pragma unroll
  for (int s = 0; s < 6; ++s) qf[s] = *(const bf16x8*)(Q + (long)(wave * 32 + r) * 96 + 16 * s + 8 * hh);
  f32x16 O[2];
#pragma unroll
  for (int i = 0; i < 16; ++i) { O[0][i] = 0.f; O[1][i] = 0.f; }
  float m = 0.f, lsum = 0.f;
  u32x4 rk0[2], rv0, rk1[2], rv1;
  const int nkt = Lk >> 6;
  attn_load_g(tid, Kn, Kr, Vt, Lk, 0, rk0, rv0);
  attn_load_g(tid, Kn, Kr, Vt, Lk, 1, rk1, rv1);
  attn_store_l(tid, smem, rk0, rv0);
  __syncthreads();
  auto tile = [&](const unsigned char* st) {
    f32x16 S[2];
    const float negm = -m;
#pragma unroll
    for (int kb = 0; kb < 2; ++kb) {
#pragma unroll
      for (int i = 0; i < 16; ++i) S[kb][i] = negm;
#pragma unroll
      for (int s = 0; s < 6; ++s) {
        const bf16x8 kf = *(const bf16x8*)(st + (kb * 32 + r) * ATT_KSTR + (16 * s + 8 * hh) * 2);
        S[kb] = __builtin_amdgcn_mfma_f32_32x32x16_bf16(kf, qf[s], S[kb], 0, 0, 0);
      }
    }
    float mx = fmaxf(fmaxf(S[0][0], S[0][1]), S[0][2]);
#pragma unroll
    for (int i = 3; i < 15; i += 2) mx = fmaxf(fmaxf(mx, S[0][i]), S[0][i + 1]);
    mx = fmaxf(mx, S[0][15]);
#pragma unroll
    for (int i = 0; i < 16; i += 2) mx = fmaxf(fmaxf(mx, S[1][i]), S[1][i + 1]);
    mx = fmaxf(mx, __shfl_xor(mx, 32));
    if (__builtin_amdgcn_ballot_w64(mx > 0.f) != 0ull) {
      const float delta = fmaxf(mx, 0.f);
      const float alpha = __builtin_amdgcn_exp2f(-delta);
      m += delta;
      lsum *= alpha;
#pragma unroll
      for (int i = 0; i < 16; ++i) { O[0][i] *= alpha; O[1][i] *= alpha; S[0][i] -= delta; S[1][i] -= delta; }
    }
    float ps = 0.f;
#pragma unroll
    for (int kb = 0; kb < 2; ++kb)
#pragma unroll
      for (int i = 0; i < 16; ++i) { const float e = __builtin_amdgcn_exp2f(S[kb][i]); S[kb][i] = e; ps += e; }
    lsum += ps;
#pragma unroll
    for (int kb = 0; kb < 2; ++kb)
#pragma unroll
      for (int s = 0; s < 2; ++s) {
        u32x4 pw;
        pw.x = pk_bf16(S[kb][8 * s + 0], S[kb][8 * s + 1]); pw.y = pk_bf16(S[kb][8 * s + 2], S[kb][8 * s + 3]);
        pw.z = pk_bf16(S[kb][8 * s + 4], S[kb][8 * s + 5]); pw.w = pk_bf16(S[kb][8 * s + 6], S[kb][8 * s + 7]);
        const bf16x8 pf = __builtin_bit_cast(bf16x8, pw);
#pragma unroll
        for (int dvb = 0; dvb < 2; ++dvb) {
          const bf16x8 vf = *(const bf16x8*)(st + ATT_VOFF + (dvb * 32 + r) * ATT_VSTR + (kb * 32 + 16 * s + 8 * hh) * 2);
          O[dvb] = __builtin_amdgcn_mfma_f32_32x32x16_bf16(vf, pf, O[dvb], 0, 0, 0);
        }
      }
  };
  for (int kt = 0; kt < nkt; kt += 2) {
    if (kt + 2 < nkt) attn_load_g(tid, Kn, Kr, Vt, Lk, kt + 2, rk0, rv0);
    __builtin_amdgcn_sched_barrier(0);
    tile(smem);
    __builtin_amdgcn_sched_barrier(0);
    attn_store_l(tid, smem + ATT_STAGE, rk1, rv1);
    __syncthreads();
    if (kt + 3 < nkt) attn_load_g(tid, Kn, Kr, Vt, Lk, kt + 3, rk1, rv1);
    __builtin_amdgcn_sched_barrier(0);
    tile(smem + ATT_STAGE);
    __builtin_amdgcn_sched_barrier(0);
    if (kt + 2 < nkt) attn_store_l(tid, smem, rk0, rv0);
    __syncthreads();
  }
  lsum += __shfl_xor(lsum, 32);
  const float inv = 1.f / lsum;
  const int t = tokbase + qb * 256 + wave * 32 + r;
  const bf16_t* gate = (const bf16_t*)(p.ws + OFF_P) + (long)t * PW + PC_CZ + h * 64 + 4 * hh;
  bf16_t* dst = (bf16_t*)(p.ws + OFF_X) + (long)t * 1024 + 512 + h * 64 + 4 * hh;
#pragma unroll
  for (int dvb = 0; dvb < 2; ++dvb)
#pragma unroll
    for (int g = 0; g < 4; ++g) {
      const u32x2 gv = *(const u32x2*)(gate + dvb * 32 + 8 * g);
      u32x2 w;
      w.x = pk_bf16(O[dvb][4 * g] * inv * bf_lo(gv.x), O[dvb][4 * g + 1] * inv * bf_hi(gv.x));
      w.y = pk_bf16(O[dvb][4 * g + 2] * inv * bf_lo(gv.y), O[dvb][4 * g + 3] * inv * bf_hi(gv.y));
      *(u32x2*)(dst + dvb * 32 + 8 * g) = w;
    }
}

DI void phase_mix(const Params& p, int l, unsigned char* smem) {
  const int tid_outer = hide_tid();
  unsigned* ctr = (unsigned*)(p.ws + OFF_CTR) + l;
  __shared__ int s_unit;
  const bf16_t* P = (const bf16_t*)(p.ws + OFF_P);
  bf16_t* X = (bf16_t*)(p.ws + OFF_X);
  const int total = 640;
  int hu = virt_block();
  const int tid0 = tid_outer;
  while (true) {
    int tid = tid0;
    asm volatile("" : "+v"(tid));
    int u;
    if (hu < 256) { u = hu; hu += gridDim.x; }
    else {
      __syncthreads();
      if (tid == 0) s_unit = 256 + (int)atomicAdd(ctr, 1u);
      __syncthreads();
      u = s_unit;
      if (u >= total) break;
      u = u < 256 + 128 ? u + 256 : u - 128;
    }
    if (u < 512) {
      const int kind = u < 256 ? 1 : 0;
      attn_unit(p, kind, kind ? u : u - 256, smem, tid);
      continue;
    }
    const bf16_t *A, *Bt;
    long lda, ldb;
    int K, tokbase, fq = -1, gcol, xcol;
    const float* sc = nullptr;
    if (u < 544) {
      const int v = u - 512, b = v >> 4;
      fq = v & 15; lda = 8192; ldb = 512; K = 512; tokbase = NPT + b * 4096 + 4 * fq; gcol = PC_AZ; xcol = 0;
      A = (const bf16_t*)(p.ws + OFF_Y1) + (((long)b * 256) * 64 + 4 * fq) * 128;
      Bt = (const bf16_t*)(p.ws + OFF_D2) + (long)fq * 256 * 512;
    } else if (u < 576) {
      const int b = u - 544;
      lda = 512; ldb = 512; K = 512; tokbase = b * 256; gcol = PC_AZ; xcol = 0;
      A = (const bf16_t*)(p.ws + OFF_DP);
      Bt = (const bf16_t*)(p.ws + OFF_ATP) + (long)b * 256 * 512;
    } else {
      const int mt = u - 576;
      lda = 256; ldb = 256; K = 256; tokbase = mt * 256; gcol = PC_BZ; xcol = 256;
      A = (const bf16_t*)(p.ws + OFF_PB) + (long)mt * 256 * 256;
      Bt = (const bf16_t*)(p.ws + OFF_POOLWT) + (long)l * 65536;
      sc = p.pool_scale + l * 256;
    }
    f32x16 acc[4][2];
    acc_zero(acc);
    gemm_main(tid, A, lda, Bt, ldb, K, acc, smem);
    if (fq >= 0) {
      epi_blocks(tid, acc, 0, 0, [&](int row, int cb, int hh, const f32x16& a) {
#pragma unroll
        for (int i = 0; i < 16; ++i) {
          const int n = cb + (i & 3) + 8 * (i >> 2) + 4 * hh;
          const long t = tokbase + (n >> 6) + 64 * (n & 63);
          X[t * 1024 + row] = f2bf(a[i] * bf2f_(P[t * PW + PC_AZ + row]));
          asm volatile("" ::: "memory");
        }
      });
      continue;
    }
    epi_blocks(tid, acc, 0, 0, [&](int row, int cb, int hh, const f32x16& a) {
      const long t = (long)tokbase + row;
      const bf16_t* gp = P + t * PW + gcol + cb + 4 * hh;
      bf16_t* d = X + t * 1024 + xcol + cb + 4 * hh;
#pragma unroll
      for (int g = 0; g < 4; ++g) {
        const u32x2 gv = *(const u32x2*)(gp + 8 * g);
        f32x4 s4 = {1.f, 1.f, 1.f, 1.f};
        if (sc) s4 = *(const f32x4*)(sc + cb + 4 * hh + 8 * g);
        u32x2 w;
        w.x = pk_bf16(a[4 * g] * s4[0] * bf_lo(gv.x), a[4 * g + 1] * s4[1] * bf_hi(gv.x));
        w.y = pk_bf16(a[4 * g + 2] * s4[2] * bf_lo(gv.y), a[4 * g + 3] * s4[3] * bf_hi(gv.y));
        *(u32x2*)(d + 8 * g) = w;
      }
    });
  }
}

DI size_t gate_image_ofs(int seg) { return seg == 0 ? OFF_G : (seg == 1 ? OFF_P : OFF_KS); }
struct GateOrder {
  int pm, pn;
  DI bool next(int i, pg8::Unit& u) const { if (i >= 3) return false; u.pm = pm; u.pn = i * 4 + pn; return true; }
  DI void a_ready(const pg8::Unit&) const {}
  DI void done(const pg8::Unit&) const {}
};
struct EpiGate {
  static constexpr bool PERM = true, AFTER_DRAIN = false;
  unsigned char* ws;
  DI void operator()(const pg8::f32x4 (&acc)[2][2][4][2], const pg8::Unit& u, int wr, int wc, int fr_, int fq_) const {
    int fr = fr_, fq = fq_;
    asm volatile("" : "+v"(fr), "+v"(fq));
    bf16_t* G = (bf16_t*)(ws + gate_image_ofs(u.pn >> 2));
    const int pnl = u.pn & 3;
#pragma unroll
    for (int bj = 0; bj < 2; ++bj)
#pragma unroll
      for (int ai = 0; ai < 2; ++ai)
#pragma unroll
        for (int m = 0; m < 4; ++m) {
          const int row = u.pm * 256 + ai * 128 + wr * 64 + m * 16 + fr, c0 = pnl * 256 + bj * 128 + wc * 32 + 8 * fq;
          const pg8::f32x4 v0 = acc[ai][bj][m][0], v1 = acc[ai][bj][m][1];
          u32x4 w; w.x = pk_bf16(sigmoid_f(v0[0]), sigmoid_f(v0[1])); w.y = pk_bf16(sigmoid_f(v0[2]), sigmoid_f(v0[3]));
          w.z = pk_bf16(sigmoid_f(v1[0]), sigmoid_f(v1[1])); w.w = pk_bf16(sigmoid_f(v1[2]), sigmoid_f(v1[3]));
          (void)row; (void)c0;
          *(u32x4*)(G + ((long)((u.pm * 4 + pnl) * 16 + (bj * 2 + ai) * 4 + m) * 512 + ((wr * 4 + wc) * 64 + fq * 16 + fr)) * 8) = w;
        }
  }
};
struct EpiBranch {
  static constexpr bool PERM = true, AFTER_DRAIN = false;
  unsigned char* ws; bf16_t* Y;
  DI void operator()(const pg8::f32x4 (&acc)[2][2][4][2], const pg8::Unit& u, int wr, int wc, int fr_, int fq_) const {
    int fr = fr_, fq = fq_;
    asm volatile("" : "+v"(fr), "+v"(fq));
    const int seg = u.koff == 0 ? 0 : (u.koff == 256 ? 1 : 2);
    const bf16_t* G = (const bf16_t*)(ws + gate_image_ofs(seg));
    bf16_t* YT = (bf16_t*)(ws + gate_image_ofs(0));
#pragma unroll
    for (int bj = 0; bj < 2; ++bj)
#pragma unroll
      for (int ai = 0; ai < 2; ++ai)
#pragma unroll
        for (int m = 0; m < 4; ++m) {
          const int row = u.pm * 256 + ai * 128 + wr * 64 + m * 16 + fr, c0 = u.pn * 256 + bj * 128 + wc * 32 + 8 * fq;
          const pg8::f32x4 v0 = acc[ai][bj][m][0], v1 = acc[ai][bj][m][1];
          const long tm = ((long)((u.pm * 4 + u.pn) * 16 + (bj * 2 + ai) * 4 + m) * 512 + ((wr * 4 + wc) * 64 + fq * 16 + fr)) * 8;
          const u32x4 gv = *(const u32x4*)(G + tm);
          u32x4 yv = {0u, 0u, 0u, 0u};
          if (seg > 0) yv = *(const u32x4*)(YT + tm);
          u32x4 w;
          w.x = pk_bf16(bf_lo(yv.x) + v0[0] * bf_lo(gv.x), bf_hi(yv.x) + v0[1] * bf_hi(gv.x));
          w.y = pk_bf16(bf_lo(yv.y) + v0[2] * bf_lo(gv.y), bf_hi(yv.y) + v0[3] * bf_hi(gv.y));
          w.z = pk_bf16(bf_lo(yv.z) + v1[0] * bf_lo(gv.z), bf_hi(yv.z) + v1[1] * bf_hi(gv.z));
          w.w = pk_bf16(bf_lo(yv.w) + v1[2] * bf_lo(gv.w), bf_hi(yv.w) + v1[3] * bf_hi(gv.w));
          if (seg < 2) *(u32x4*)(YT + tm) = w;
          else *(u32x4*)(Y + (long)row * 1024 + c0) = w;
        }
  }
};
DI void phase_merge(const Params& p, int l, unsigned char* smem) {
  const bf16_t* X = (const bf16_t*)(p.ws + OFF_X);
  const bf16_t* XN = (const bf16_t*)(p.ws + OFF_XN);
  const bf16_t* WbrT = (const bf16_t*)(p.ws + OFF_WBRT) + (long)l * 1024 * 1024;
  const bf16_t* WgT = (const bf16_t*)(p.ws + OFF_WGT) + (long)l * 3072 * LDX;
  bf16_t* Y = (bf16_t*)(p.ws + OFF_Y);
  pg8::StaticOrder S;
  S.init(NTOK, 1024, gridDim.x, blockIdx.x);
  pg8::Unit tile;
#pragma unroll 1
  for (int ti = 0; S.next(ti, tile); ++ti) {
    {
      pg8::Gemm g{XN, WgT, NTOK, 3072, 1024, LDX, LDX};
      GateOrder O{tile.pm, tile.pn};
      EpiGate E{p.ws};
      __syncthreads();
      pg8::gemm_phase<EpiGate, GateOrder, true, true>((PG8_LAS unsigned char*)smem, g, O, E);
    }
    {
      pg8::Gemm g{X, WbrT, NTOK, 1024, 256, 1024, 1024};
      struct BranchOrder {
        int pm, pn;
        DI bool next(int i, pg8::Unit& u) const { if (i >= 3) return false; u.pm = pm; u.pn = pn; u.koff = i * 256; u.K = i == 2 ? 512 : 256; return true; }
        DI void a_ready(const pg8::Unit&) const {}
        DI void done(const pg8::Unit&) const {}
      } O{tile.pm, tile.pn};
      EpiBranch E{p.ws, Y};
      __syncthreads();
      pg8::gemm_phase<EpiBranch, BranchOrder, true, true>((PG8_LAS unsigned char*)smem, g, O, E);
    }
  }
}

struct EpiWout {
  static constexpr bool PERM = true, AFTER_DRAIN = false;
  const float* x_prompt; const float* x_sample; const bf16_t* hb_in; bf16_t* hb_out; const float* MODF; int l;
  DI void operator()(const pg8::f32x4 (&acc)[2][2][4][2], const pg8::Unit& u, int wr, int wc, int fr_, int fq_) const {
    int fr = fr_, fq = fq_;
    asm volatile("" : "+v"(fr), "+v"(fq));
#pragma unroll
    for (int bj = 0; bj < 2; ++bj)
#pragma unroll
      for (int ai = 0; ai < 2; ++ai)
#pragma unroll
        for (int m = 0; m < 4; ++m) {
          const int row = u.pm * 256 + ai * 128 + wr * 64 + m * 16 + fr, c0 = u.pn * 256 + bj * 128 + wc * 32 + 8 * fq;
          const float* gt = MODF + tok_mod_idx(row) * 3072 + 2048 + c0;
          float hv[8];
          if (l == 0) {
            const float* hp = (row < NPT ? x_prompt + (long)row * 1024 : x_sample + (long)(row - NPT) * 1024) + c0;
            const f32x4 h0 = *(const f32x4*)hp, h1 = *(const f32x4*)(hp + 4);
#pragma unroll
            for (int e = 0; e < 4; ++e) { hv[e] = h0[e]; hv[4 + e] = h1[e]; }
          } else {
            const u32x4 hw = *(const u32x4*)(hb_in + (long)row * 1024 + c0);
            hv[0] = bf_lo(hw.x); hv[1] = bf_hi(hw.x); hv[2] = bf_lo(hw.y); hv[3] = bf_hi(hw.y);
            hv[4] = bf_lo(hw.z); hv[5] = bf_hi(hw.z); hv[6] = bf_lo(hw.w); hv[7] = bf_hi(hw.w);
          }
          const f32x4 g0 = *(const f32x4*)gt, g1 = *(const f32x4*)(gt + 4);
          const pg8::f32x4 v0 = acc[ai][bj][m][0], v1 = acc[ai][bj][m][1];
          u32x4 w;
          w.x = pk_bf16(hv[0] + g0[0] * v0[0], hv[1] + g0[1] * v0[1]); w.y = pk_bf16(hv[2] + g0[2] * v0[2], hv[3] + g0[3] * v0[3]);
          w.z = pk_bf16(hv[4] + g1[0] * v1[0], hv[5] + g1[1] * v1[1]); w.w = pk_bf16(hv[6] + g1[2] * v1[2], hv[7] + g1[3] * v1[3]);
          *(u32x4*)(hb_out + (long)row * 1024 + c0) = w;
        }
  }
};
DI void phase_wout(const Params& p, int l, unsigned char* smem) {
  pg8::Gemm g{(const bf16_t*)(p.ws + OFF_Y), (const bf16_t*)(p.ws + OFF_WOUTT) + (long)l * 1024 * 1024, NTOK, 1024, 1024, 1024, 1024};
  pg8::StaticOrder S;
  S.init(NTOK, 1024, gridDim.x, blockIdx.x);
  EpiWout E{p.x_prompt, p.x_sample, (const bf16_t*)p.out, l == 0 ? (bf16_t*)p.out : (bf16_t*)(p.ws + OFF_XN), (const float*)(p.ws + OFF_MODF) + l * 9216, l};
  __syncthreads();
  pg8::gemm_phase<EpiWout, pg8::StaticOrder, true, true>((PG8_LAS unsigned char*)smem, g, S, E);
}

DI void phase_final(const Params& p) {
  const int tid = hide_tid();
  const int wave = tid >> 6, lane = tid & 63;
  for (int row = blockIdx.x * NWAVE + wave; row < NTOK; row += gridDim.x * NWAVE) {
    float* src = p.out + (long)row * 1024;
    const bf16_t* srcb = (const bf16_t*)(p.ws + OFF_XN) + (long)row * 1024;
    f32x4 x[4];
    float ss = 0.f;
#pragma unroll
    for (int j = 0; j < 4; ++j) {
      const u32x2 hw = *(const u32x2*)(srcb + j * 256 + lane * 4);
      x[j] = (f32x4){bf_lo(hw.x), bf_hi(hw.x), bf_lo(hw.y), bf_hi(hw.y)};
      ss += x[j][0] * x[j][0] + x[j][1] * x[j][1] + x[j][2] * x[j][2] + x[j][3] * x[j][3];
    }
    ss = wave_sum(ss);
    const float r = rsqrtf(ss * (1.f / 1024.f) + EPS);
#pragma unroll
    for (int j = 0; j < 4; ++j) {
      const f32x4 g = *(const f32x4*)(p.final_norm_g + j * 256 + lane * 4);
      f32x4 o = {x[j][0] * r * g[0], x[j][1] * r * g[1], x[j][2] * r * g[2], x[j][3] * r * g[3]};
      *(f32x4*)(src + j * 256 + lane * 4) = o;
    }
  }
}

#define XB_TMO      128
#define XB_XCNT(j)  (256  + 64 * (j))
#define XB_XSUB(j)  (1280 + 64 * (j))
#define XB_XGEN(j)  (2304 + 64 * (j))
#define XB_TOP      3328
#define XB_TOPGEN   3392
#define XB_SPIN_CAP (1u << 18)
#define LAS __attribute__((address_space(3)))
DI unsigned xb_ld(unsigned* p)              { return __hip_atomic_load(p, __ATOMIC_RELAXED, __HIP_MEMORY_SCOPE_AGENT); }
DI unsigned xb_add(unsigned* p, unsigned v) { return __hip_atomic_fetch_add(p, v, __ATOMIC_RELAXED, __HIP_MEMORY_SCOPE_AGENT); }
DI unsigned xb_xcc_id() { return (unsigned)__builtin_amdgcn_s_getreg((3 << 11) | 20) & 0xFu; }
#define XB_SPIN(cond, bar) do { unsigned _sp = 0; while (cond) { __builtin_amdgcn_s_sleep(1); \
    if ((++_sp & 255u) == 0u) { if (xb_ld(&(bar)[XB_TMO])) break; if (_sp > XB_SPIN_CAP) { atomicAdd(&(bar)[XB_TMO], 1u); break; } } } } while (0)
struct XcdBarrier { unsigned* bar; unsigned x; volatile LAS unsigned* st; };
DI XcdBarrier xcd_barrier_post(unsigned* bar, volatile LAS unsigned* st) {
  XcdBarrier b; b.bar = bar; b.x = xb_xcc_id(); b.st = st;
  if (threadIdx.x == 0) (void)xb_add(&bar[XB_XCNT(b.x)], 1u);
  return b;
}
DI void xcd_barrier_complete(unsigned* bar, unsigned x, unsigned& nloc, unsigned& nx) {
  const unsigned G = gridDim.x * gridDim.y * gridDim.z;
  unsigned sum, cnt, mine, sp = 0u;
  for (;;) {
    sum = 0u; cnt = 0u; mine = 0u;
#pragma unroll
    for (unsigned j = 0; j < 16; ++j) { const unsigned c = xb_ld(&bar[XB_XCNT(j)]); sum += c; cnt += (c > 0u) ? 1u : 0u; mine = (j == x) ? c : mine; }
    if (sum == G) break;
    __builtin_amdgcn_s_sleep(1);
    if ((++sp & 255u) == 0u) { if (xb_ld(&bar[XB_TMO])) break; if (sp > XB_SPIN_CAP) { atomicAdd(&bar[XB_TMO], 1u); break; } }
  }
  nloc = mine > 0u ? mine : 1u; nx = cnt > 0u ? cnt : 1u;
}
DI void xcd_barrier(unsigned* bar_in, volatile LAS unsigned* st_in) {
  XcdBarrier b; b.bar = bar_in; b.x = xb_xcc_id(); b.st = st_in;
  asm volatile("s_waitcnt vmcnt(0)" ::: "memory");
  __syncthreads();
  if (threadIdx.x == 0) {
    unsigned* bar = b.bar;
    __builtin_amdgcn_s_waitcnt(0);
    unsigned nloc = b.st[0], nx = b.st[1];
    if (nloc == 0u) { xcd_barrier_complete(bar, b.x, nloc, nx); b.st[0] = nloc; b.st[1] = nx; }
    const unsigned old = xb_add(&bar[XB_XSUB(b.x)], 1u);
    const unsigned gen = old / nloc;
    if (old + 1u == (gen + 1u) * nloc) {
      __builtin_amdgcn_fence(__ATOMIC_RELEASE, "agent");
      asm volatile("s_waitcnt vmcnt(0)" ::: "memory");
      const unsigned og = xb_add(&bar[XB_TOP], 1u);
      const unsigned tg = og / nx;
      if (og + 1u == (tg + 1u) * nx) xb_add(&bar[XB_TOPGEN], 1u);
      else XB_SPIN(xb_ld(&bar[XB_TOPGEN]) == tg, bar);
      __builtin_amdgcn_fence(__ATOMIC_ACQUIRE, "agent");
      xb_add(&bar[XB_XGEN(b.x)], 1u);
      asm volatile("s_waitcnt vmcnt(0)" ::: "memory");
    } else {
      XB_SPIN(xb_ld(&bar[XB_XGEN(b.x)]) == gen, bar);
      __builtin_amdgcn_fence(__ATOMIC_ACQUIRE, "agent");
      asm volatile("s_waitcnt vmcnt(0)" ::: "memory");
    }
  }
  __syncthreads();
}

#ifndef PROBE_MASK
#define PROBE_MASK 0
#endif
#define GSYNC() xcd_barrier((unsigned*)(p.ws + OFF_BAR), (volatile LAS unsigned*)&xb_words)
#define PROBE_REP(bit, stmt) do { stmt; if ((PROBE_MASK >> (bit)) & 1) { if (l == 0) { GSYNC(); stmt; } } } while (0)
__global__ void __launch_bounds__(NTHR, 2) fwd_mega(Params p) {
  cg::grid_group grid = cg::this_grid();
  extern __shared__ __attribute__((aligned(16))) unsigned char smem[];
  __shared__ uint4 xb_words;
  if (threadIdx.x == 0) xb_words = make_uint4(0u, 0u, 0u, 0u);
  __syncthreads();
  (void)xcd_barrier_post((unsigned*)(p.ws + OFF_BAR), (volatile LAS unsigned*)&xb_words);
  if (p.ph_lo) grid.sync();
  phase_prep_a(p, smem);
  GSYNC();
  phase_prep_b(p, smem);
  GSYNC();
  if ((PROBE_MASK >> 8) & 1) { for (int i = 0; i < 20; ++i) GSYNC(); }
  if ((PROBE_MASK >> 9) & 1) { phase_prep_a(p, smem); GSYNC(); phase_prep_b(p, smem); GSYNC(); }
#pragma unroll 1
  for (int l = 0; l < 2; ++l) {
    PROBE_REP(0, phase_xn(p, l));
    GSYNC();
    PROBE_REP(1, phase_win(p, l, smem));
    GSYNC();
    {
      const int G = gridDim.x, nwb = G > 64 ? 64 : G, bid = blockIdx.x;
      if (bid < nwb) phase_win_tail(p, l, smem, nwb);
      if (bid >= nwb || G == nwb) {
        const int first = G == nwb ? bid : bid - nwb, stride = G == nwb ? G : G - nwb;
        phase_lat(p, l, first, stride);
        phase_aux(p, l, smem, first, stride);
      }
    }
    GSYNC();
    PROBE_REP(3, phase_up(p, l, smem));
    GSYNC();
    PROBE_REP(4, phase_mix(p, l, smem));
    GSYNC();
    PROBE_REP(5, phase_merge(p, l, smem));
    GSYNC();
    PROBE_REP(6, phase_wout(p, l, smem));
    GSYNC();
  }
  phase_final(p);
}

extern "C" void kernel_launch(void* const* d_in, const int* in_sizes, int n_in, void* d_out, int out_size,
                              void* d_ws, size_t ws_size, hipStream_t stream) {
  constexpr size_t kDynLds = 131072;
  static int grid_blocks = 0;
  if (!grid_blocks) {
    int dev = 0, cus = 0, per_cu = 0;
    (void)hipGetDevice(&dev);
    (void)hipDeviceGetAttribute(&cus, hipDeviceAttributeMultiprocessorCount, dev);
    (void)hipFuncSetAttribute((const void*)fwd_mega, hipFuncAttributeMaxDynamicSharedMemorySize, (int)kDynLds);
    (void)hipOccupancyMaxActiveBlocksPerMultiprocessor(&per_cu, fwd_mega, NTHR, kDynLds);
    if (per_cu > 1) per_cu = 1;
    if (per_cu < 1) per_cu = 1;
    grid_blocks = cus * per_cu;
  }
  if (ws_size < WS_TOTAL) { fprintf(stderr, "workspace too small: %zu < %zu\n", ws_size, (size_t)WS_TOTAL); return; }
  Params p{};
  const float** f = (const float**)&p;
  for (int i = 0; i < 21; ++i) f[i] = (const float*)d_in[i];
  p.out = (float*)d_out;
  p.ws = (unsigned char*)d_ws;
  (void)hipMemsetAsync((unsigned char*)d_ws + OFF_BAR, 0, BAR_BYTES, stream);
  void* args[] = {&p};
  hipError_t e = hipLaunchCooperativeKernel((void*)fwd_mega, dim3(grid_blocks), dim3(NTHR), args, kDynLds, stream);
  if (e != hipSuccess) fprintf(stderr, "cooperative launch failed: %s (grid %d)\n", hipGetErrorString(e), grid_blocks);
}
```

```cpp
#include <hip/hip_runtime.h>
#include <hip/hip_cooperative_groups.h>
#include <cstdio>
#include <cstdint>
namespace cg = cooperative_groups;

#define DI __device__ __forceinline__
typedef unsigned short bf16_t;
typedef short bf16x8 __attribute__((ext_vector_type(8)));
typedef float f32x16 __attribute__((ext_vector_type(16)));
typedef float f32x4 __attribute__((ext_vector_type(4)));
typedef float f32x2 __attribute__((ext_vector_type(2)));
typedef unsigned u32x4 __attribute__((ext_vector_type(4)));
typedef unsigned u32x2 __attribute__((ext_vector_type(2)));
typedef __bf16 bf16x2_t __attribute__((ext_vector_type(2)));

constexpr int NTHR = 512, NWAVE = 8;
constexpr int D = 1024, NTOK = 16384, NPT = 8192, LP = 256, LS = 4096, LKS = 4608, PAST = 512;
constexpr int NEXT = 2208, NEXTP = 2304, PW = 1280, LATW = 416;
constexpr int LDX = 1024;
constexpr int PC_AZ = 0, PC_BIN = 256, PC_BZ = 512, PC_CZ = 768;
constexpr int NROWS_KV = NTOK + 2 * PAST;
constexpr float EPS = 1e-6f;
constexpr float QSCALE = 0.10206207261596577f * 1.4426950408889634f;

constexpr size_t al256(size_t x) { return (x + 255) & ~(size_t)255; }
constexpr size_t OFF_WINT = 0;
constexpr size_t OFF_WGT = OFF_WINT + al256((size_t)2 * NEXTP * LDX * 2);
constexpr size_t OFF_WQT = OFF_WGT + al256((size_t)2 * 3072 * LDX * 2);
constexpr size_t OFF_WKVT = OFF_WQT + al256((size_t)2 * 768 * 256 * 2);
constexpr size_t OFF_WBRT = OFF_WKVT + al256((size_t)2 * 1024 * 128 * 2);
constexpr size_t OFF_WOUTT = OFF_WBRT + al256((size_t)2 * 1024 * 1024 * 2);
constexpr size_t OFF_POOLWT = OFF_WOUTT + al256((size_t)2 * 1024 * 1024 * 2);
constexpr size_t OFF_MODP = OFF_POOLWT + al256((size_t)2 * 256 * 256 * 2);
constexpr size_t OFF_MODF = OFF_MODP + al256((size_t)16 * 2 * 3 * 3072 * 4);
constexpr size_t OFF_ROPE = OFF_MODF + al256((size_t)2 * 3 * 3072 * 4);
constexpr size_t OFF_DP = OFF_ROPE + al256((size_t)2 * 4096 * 32 * 4);
constexpr size_t OFF_A1 = OFF_DP + al256((size_t)256 * 512 * 2);
constexpr size_t OFF_D2 = OFF_A1 + al256((size_t)256 * 256 * 2);
constexpr size_t OFF_XN = OFF_D2 + al256((size_t)16 * 256 * 512 * 2);
constexpr size_t OFF_P = OFF_XN + al256((size_t)NTOK * LDX * 2);
constexpr size_t OFF_X = OFF_P + al256((size_t)NTOK * PW * 2);
constexpr size_t OFF_LAT = OFF_X;
constexpr size_t OFF_ATP = OFF_X + al256((size_t)NTOK * 1024 * 2);
constexpr size_t OFF_G = OFF_ATP;
constexpr size_t OFF_Z = OFF_ATP + al256((size_t)32 * 256 * 512 * 2);
constexpr size_t OFF_Y1 = OFF_Z + al256((size_t)2 * 256 * 64 * 128 * 2);
constexpr size_t OFF_QN = OFF_Y1 + al256((size_t)2 * 256 * 64 * 128 * 2);
constexpr size_t OFF_CKVB = OFF_QN + al256((size_t)NTOK * 256 * 2);
constexpr size_t OFF_Q = OFF_CKVB + al256((size_t)NROWS_KV * 128 * 2);
constexpr size_t OFF_Y = OFF_Q;
constexpr size_t OFF_KP = OFF_Q + al256((size_t)NTOK * 8 * 96 * 2);
constexpr size_t OFF_KS = OFF_KP + al256((size_t)32 * 8 * 256 * 64 * 2);
constexpr size_t OFF_KR = OFF_KS + al256((size_t)2 * 8 * LKS * 64 * 2);
constexpr size_t OFF_VTP = OFF_KR + al256((size_t)(NPT + 2 * LKS) * 32 * 2);
constexpr size_t OFF_VTS = OFF_VTP + al256((size_t)32 * 8 * 64 * 256 * 2);
constexpr size_t OFF_PB = OFF_VTS + al256((size_t)2 * 8 * 64 * LKS * 2);
constexpr size_t OFF_CTR = OFF_PB + al256((size_t)NTOK * 256 * 2);
constexpr size_t OFF_BAR = OFF_CTR + 256;
constexpr size_t BAR_BYTES = 3456 * 4;
constexpr size_t WS_TOTAL = OFF_BAR + al256(BAR_BYTES);
static_assert(OFF_KS - OFF_Q >= (size_t)NTOK * 1024 * 2, "Y overlay");
static_assert(OFF_CKVB - OFF_ATP >= (size_t)NTOK * 1024 * 2, "G overlay");
static_assert(OFF_CTR - OFF_KS >= (size_t)NTOK * 1024 * 2 && OFF_X - OFF_P >= (size_t)NTOK * 1024 * 2, "G1/G2 overlays");
static_assert((size_t)NTOK * LATW * 4 <= (size_t)NTOK * 1024 * 2, "LAT overlay");
static_assert(WS_TOTAL <= (size_t)256 * 1024 * 1024, "workspace");

constexpr long OUT_CKV = (long)NTOK * 1024;
constexpr long OUT_KR = OUT_CKV + (long)32 * 2 * 256 * 128;

struct Params {
  const float *x_prompt, *x_sample, *cache_ckv, *cache_krope, *c, *c_ctx, *norm_g, *w_mod, *b_mod, *w_in, *pool_w, *pool_scale,
      *q_norm_g, *w_q_up, *kv_norm_g, *w_kv_up, *w_br_a, *w_br_b, *w_br_c, *w_out, *final_norm_g;
  float* out;
  unsigned char* ws;
  int ph_lo, ph_hi;
};

DI unsigned pk_bf16(float lo, float hi) { f32x2 v = {lo, hi}; bf16x2_t r = __builtin_convertvector(v, bf16x2_t); return __builtin_bit_cast(unsigned, r); }
DI bf16_t f2bf(float x) { return (bf16_t)(pk_bf16(x, 0.f) & 0xffffu); }
DI float bf_lo(unsigned u) { return __uint_as_float(u << 16); }
DI float bf2f_(bf16_t u) { return __uint_as_float(((unsigned)u) << 16); }
DI float bf_hi(unsigned u) { return __uint_as_float(u & 0xffff0000u); }
DI float sigmoid_f(float x) { return __builtin_amdgcn_rcpf(1.f + __expf(-x)); }
DI float silu_f(float x) { return x * sigmoid_f(x); }
DI float wave_sum(float v) {
#pragma unroll
  for (int o = 32; o > 0; o >>= 1) v += __shfl_xor(v, o);
  return v;
}
DI int hide_tid() { int t = threadIdx.x; asm volatile("" : "+v"(t)); return t; }
DI int virt_block() { const int g8 = gridDim.x >> 3; return (blockIdx.x & 7) * g8 + (blockIdx.x >> 3); }
DI void tile_decode(int u, int NT, int& mt, int& nt) { const int gm = u / (8 * NT), r = u - gm * 8 * NT; nt = r >> 3; mt = gm * 8 + (r & 7); }
DI int tok_mod_idx(int t) { return t < NPT ? 0 : 1 + ((t - NPT) >> 12); }

#define LDSP __attribute__((address_space(3)))
constexpr int GM_STAGE = 65536, GM_BOFF = 32768;
DI void gemm_dma(int tid, const bf16_t* __restrict__ A, long lda, const bf16_t* __restrict__ Bt, long ldb, int k0, unsigned char* st) {
  const int wave = tid >> 6, lane = tid & 63, rl = lane >> 3, slot = lane & 7;
#pragma unroll
  for (int q = 0; q < 4; ++q) {
    const int r = 64 * q + 8 * wave + rl;
    const int ch = slot ^ ((r >> 1) & 7);
    unsigned char* dst = st + (8 * q + wave) * 1024;
    __builtin_amdgcn_global_load_lds((const unsigned*)(A + (long)r * lda + k0 + ch * 8), (LDSP unsigned*)dst, 16, 0, 0);
    __builtin_amdgcn_global_load_lds((const unsigned*)(Bt + (long)r * ldb + k0 + ch * 8), (LDSP unsigned*)(dst + GM_BOFF), 16, 0, 0);
  }
}
DI void gemm_dma_b(int tid, const bf16_t* __restrict__ Bt, long ldb, int k0, unsigned char* st) {
  const int wave = tid >> 6, lane = tid & 63, rl = lane >> 3, slot = lane & 7;
#pragma unroll
  for (int q = 0; q < 4; ++q) {
    const int r = 64 * q + 8 * wave + rl;
    const int ch = slot ^ ((r >> 1) & 7);
    __builtin_amdgcn_global_load_lds((const unsigned*)(Bt + (long)r * ldb + k0 + ch * 8), (LDSP unsigned*)(st + (8 * q + wave) * 1024 + GM_BOFF), 16, 0, 0);
  }
}
DI void gemm_compute(int tid, const unsigned char* st, f32x16 (&acc)[4][2]) {
  const int wave = tid >> 6, lane = tid & 63, wm = wave >> 2, wn = wave & 3, r = lane & 31, hh = lane >> 5;
#pragma unroll
  for (int s = 0; s < 4; ++s) {
    const int sw = ((2 * s + hh) ^ ((r >> 1) & 7)) << 4;
    bf16x8 af[4], bf[2];
#pragma unroll
    for (int i = 0; i < 4; ++i) af[i] = *(const bf16x8*)(st + (wm * 128 + i * 32 + r) * 128 + sw);
#pragma unroll
    for (int i = 0; i < 2; ++i) bf[i] = *(const bf16x8*)(st + GM_BOFF + (wn * 64 + i * 32 + r) * 128 + sw);
#pragma unroll
    for (int mi = 0; mi < 4; ++mi)
#pragma unroll
      for (int ni = 0; ni < 2; ++ni) acc[mi][ni] = __builtin_amdgcn_mfma_f32_32x32x16_bf16(bf[ni], af[mi], acc[mi][ni], 0, 0, 0);
  }
}
DI void gemm_main(int tid, const bf16_t* __restrict__ A, long lda, const bf16_t* __restrict__ Bt, long ldb, int K, f32x16 (&acc)[4][2], unsigned char* smem) {
  const int nk = K >> 6;
  gemm_dma(tid, A, lda, Bt, ldb, 0, smem);
  asm volatile("s_waitcnt vmcnt(0)" ::: "memory");
  __syncthreads();
  for (int kt = 0; kt < nk; ++kt) {
    if (kt + 1 < nk) gemm_dma(tid, A, lda, Bt, ldb, (kt + 1) * 64, smem + ((kt + 1) & 1) * GM_STAGE);
    gemm_compute(tid, smem + (kt & 1) * GM_STAGE, acc);
    asm volatile("s_waitcnt vmcnt(0)" ::: "memory");
    __syncthreads();
  }
}
DI void acc_zero(f32x16 (&acc)[4][2]) {
#pragma unroll
  for (int a = 0; a < 4; ++a)
#pragma unroll
    for (int b = 0; b < 2; ++b)
#pragma unroll
      for (int i = 0; i < 16; ++i) acc[a][b][i] = 0.f;
}
template <class F> DI void epi_blocks(int tid, const f32x16 (&acc)[4][2], int m0, int n0, F f) {
  const int wave = tid >> 6, lane = tid & 63, wm = wave >> 2, wn = wave & 3, r = lane & 31, hh = lane >> 5;
#pragma unroll
  for (int mi = 0; mi < 4; ++mi)
#pragma unroll
    for (int ni = 0; ni < 2; ++ni) f(m0 + wm * 128 + mi * 32 + r, n0 + wn * 64 + ni * 32, hh, acc[mi][ni]);
}

namespace pg8 {
#define PG8_LAS __attribute__((address_space(3)))
typedef float f32x4 __attribute__((ext_vector_type(4)));
constexpr int BM = 256, BK = 64, HALF = 128, HTB = HALF * BK * 2, STAGE_BYTES = 8 * HTB, NXCD = 8, WGM = 8;
__host__ __device__ __forceinline__ int lds_byte(int r, int c) { const int st = (r >> 4) * 2 + (c >> 5), rr = r & 15, cc = c & 31, ob = rr * 64 + cc * 2; return st * 1024 + (ob ^ (((ob >> 9) & 1) << 5)); }
__host__ __device__ __forceinline__ void stage_rc(int b, int& R, int& C) { const int st = b / 1024, sb = b % 1024, swz = sb ^ (((sb >> 9) & 1) << 5); R = (st >> 1) * 16 + swz / 64; C = (st & 1) * 32 + (swz % 64) / 2; }
__host__ __device__ __forceinline__ int perm32(int rho) { const int n = rho >> 4, i = rho & 15; return 8 * (i >> 2) + 4 * n + (i & 3); }
struct Unit { int pm, pn; int koff = 0, K = 0; };
struct Gemm { const bf16_t* A; const bf16_t* Bt; int M, N, K; int lda, ldb; };
struct StaticOrder {
    int nM, nN, nwg, G, c;
    __host__ __device__ void init(int M, int N, int G_, int c_) { nM = M / BM; nN = N / BM; nwg = nM * nN; G = G_; c = c_; }
    __host__ __device__ bool next(int i, Unit& u) const {
        const long L = (long)i * G + c; if (L >= nwg) return false;
        int wgid = (int)L; { const int q = nwg / NXCD, r = nwg % NXCD, xcd = wgid % NXCD, off = wgid / NXCD; wgid = (xcd < r ? xcd * (q + 1) : r * (q + 1) + (xcd - r) * q) + off; }
        const int nig = WGM * nN, gid = wgid / nig, fm = gid * WGM, gsz = (nM - fm) < WGM ? (nM - fm) : WGM;
        u.pm = fm + ((wgid % nig) % gsz); u.pn = (wgid % nig) / gsz; return true;
    }
    __device__ __forceinline__ void a_ready(const Unit&) const {}
    __device__ __forceinline__ void done(const Unit&) const {}
};
template <class Epi, class Sched, bool ALIGN_EPI = false, bool SP2 = false>
__device__ __forceinline__ void gemm_phase(PG8_LAS unsigned char* lds, const Gemm g, const Sched& S, const Epi& E) {
    int tid = threadIdx.x;
    asm volatile("" : "+v"(tid));
    const int wid = __builtin_amdgcn_readfirstlane(tid >> 6), lane = tid & 63, wr = wid >> 2, wc = wid & 3, fr = lane & 15, fq = lane >> 4;
    int K = g.K;
    asm volatile("" : "+s"(K));
    int nt = K / BK;
    unsigned voffA[2], voffB[2];
#pragma unroll
    for (int i = 0; i < 2; ++i) { int R, C; stage_rc(tid * 16 + i * 8192, R, C); const int Rb = Epi::PERM ? ((R & ~31) + perm32(R & 31)) : R;
        voffA[i] = (unsigned)(R * g.lda + C) * 2u; voffB[i] = (unsigned)(Rb * g.ldb + C) * 2u; }
    const size_t kstep = (size_t)(BK * 2);
    const size_t hstepA = (size_t)HALF * g.lda * 2, hstepB = (size_t)HALF * g.ldb * 2;
    const size_t tstepA = 2 * hstepA, tstepB = 2 * hstepB;
    const unsigned ldsw = (unsigned)wid * 1024u;
    const int aoff = lds_byte(wr * 64 + fr, fq * 8), boff = lds_byte(wc * 32 + fr, fq * 8);
#define PG8_SA(b, h) (((b) * 2 + (h)) * HTB)
#define PG8_SB(b, h) ((4 + (b) * 2 + (h)) * HTB)
#define PG8_STAGE(bufoff, gbase, voff) do { _Pragma("unroll") for (int _i = 0; _i < 2; ++_i) \
        __builtin_amdgcn_global_load_lds((const unsigned*)((const char*)(gbase) + (voff)[_i]), (PG8_LAS unsigned*)(lds + (bufoff) + ldsw + _i * 8192), 16, 0, 0); } while (0)
#define PG8_LDA(dst, b, h) do { _Pragma("unroll") for (int m = 0; m < 4; ++m) _Pragma("unroll") for (int k = 0; k < 2; ++k) dst[m][k] = *(const PG8_LAS bf16x8*)(lds + PG8_SA(b, h) + aoff + m * 2048 + k * 1024); } while (0)
#define PG8_LDB(dst, b, h) do { _Pragma("unroll") for (int n = 0; n < 2; ++n) _Pragma("unroll") for (int k = 0; k < 2; ++k) dst[n][k] = *(const PG8_LAS bf16x8*)(lds + PG8_SB(b, h) + boff + n * 2048 + k * 1024); } while (0)
#define PG8_MMA(ai, bj, At, Bt) do { __builtin_amdgcn_s_setprio(1); _Pragma("unroll") for (int m = 0; m < 4; ++m) _Pragma("unroll") for (int n = 0; n < 2; ++n) _Pragma("unroll") for (int k = 0; k < 2; ++k) \
        acc[ai][bj][m][n] = __builtin_amdgcn_mfma_f32_16x16x32_bf16(Bt[n][k], At[m][k], acc[ai][bj][m][n], 0, 0, 0); __builtin_amdgcn_s_setprio(0); } while (0)
#define PG8_WAIT_V(n) asm volatile("s_waitcnt vmcnt(" #n ")" ::: "memory")
#define PG8_WAIT_L(n) asm volatile("s_waitcnt lgkmcnt(" #n ")" ::: "memory")
#define PG8_BAR __builtin_amdgcn_s_barrier()
#define PG8_SCHED __builtin_amdgcn_sched_barrier(0)
    Unit cur, nxt; int ui = 0;
    if (!S.next(0, cur)) return;
    f32x4 acc[2][2][4][2];
#pragma unroll
    for (int a = 0; a < 2; ++a)
#pragma unroll
        for (int b = 0; b < 2; ++b)
#pragma unroll
            for (int m = 0; m < 4; ++m)
#pragma unroll
                for (int n = 0; n < 2; ++n) acc[a][b][m][n] = (f32x4){0.f, 0.f, 0.f, 0.f};
    bf16x8 At[4][2], B0[2][2], B1[2][2];
    if (cur.K) nt = cur.K / BK;
    const char* cA = (const char*)g.A + (size_t)cur.pm * tstepA + (size_t)cur.koff * 2; const char* cB = (const char*)g.Bt + (size_t)cur.pn * tstepB + (size_t)cur.koff * 2;
    S.a_ready(cur);
    if constexpr (SP2) {
        PG8_STAGE(PG8_SB(0, 0), cB, voffB); PG8_STAGE(PG8_SB(0, 1), cB + hstepB, voffB); PG8_STAGE(PG8_SA(0, 0), cA, voffA); PG8_STAGE(PG8_SA(0, 1), cA + hstepA, voffA);
        if (wr == 1) PG8_BAR;
        PG8_WAIT_V(2); PG8_BAR;
        PG8_STAGE(PG8_SB(1, 0), cB + kstep, voffB); PG8_STAGE(PG8_SA(1, 0), cA + kstep, voffA); PG8_STAGE(PG8_SB(1, 1), cB + hstepB + kstep, voffB);
        PG8_WAIT_V(6); PG8_BAR;
    } else {
        PG8_STAGE(PG8_SB(0, 0), cB, voffB); PG8_STAGE(PG8_SA(0, 0), cA, voffA); PG8_STAGE(PG8_SB(0, 1), cB + hstepB, voffB); PG8_STAGE(PG8_SA(0, 1), cA + hstepA, voffA);
        if (wr == 1) PG8_BAR;
        PG8_WAIT_V(4); PG8_BAR;
        PG8_STAGE(PG8_SB(1, 0), cB + kstep, voffB); PG8_STAGE(PG8_SA(1, 0), cA + kstep, voffA); PG8_STAGE(PG8_SB(1, 1), cB + hstepB + kstep, voffB);
        PG8_WAIT_V(6); PG8_BAR;
    }
    for (;;) {
        const bool has_next = S.next(ui + 1, nxt);
        const char* nA = has_next ? (const char*)g.A + (size_t)nxt.pm * tstepA + (size_t)nxt.koff * 2 : cA; const char* nB = has_next ? (const char*)g.Bt + (size_t)nxt.pn * tstepB + (size_t)nxt.koff * 2 : cB;
        for (int t = 0; t < nt; t += 2) {
            const bool last = (t == nt - 2);
            const char* a1 = cA + (size_t)(t + 1) * kstep;
            const char* a2 = last ? nA : cA + (size_t)(t + 2) * kstep; const char* b2 = last ? nB : cB + (size_t)(t + 2) * kstep;
            const char* a3 = a2 + kstep; const char* b3 = b2 + kstep;
            if (last && has_next) S.a_ready(nxt);
            if constexpr (SP2) {
            PG8_LDB(B0, 0, 0); PG8_LDB(B1, 0, 1); PG8_SCHED; PG8_LDA(At, 0, 0); PG8_STAGE(PG8_SA(1, 1), a1 + hstepA, voffA);
            PG8_WAIT_V(8); PG8_WAIT_L(0); PG8_BAR; PG8_MMA(0, 0, At, B0); PG8_MMA(0, 1, At, B1); PG8_BAR; PG8_SCHED;
            PG8_LDA(At, 0, 1); PG8_STAGE(PG8_SB(0, 0), b2, voffB); PG8_STAGE(PG8_SB(0, 1), b2 + hstepB, voffB); PG8_STAGE(PG8_SA(0, 0), a2, voffA);
            PG8_WAIT_V(8); PG8_WAIT_L(0); PG8_BAR; PG8_MMA(1, 0, At, B0); PG8_MMA(1, 1, At, B1); PG8_BAR; PG8_SCHED;
            PG8_LDB(B0, 1, 0); PG8_LDB(B1, 1, 1); PG8_SCHED; PG8_LDA(At, 1, 0); PG8_STAGE(PG8_SA(0, 1), a2 + hstepA, voffA);
            PG8_WAIT_V(8); PG8_WAIT_L(0); PG8_BAR; PG8_MMA(0, 0, At, B0); PG8_MMA(0, 1, At, B1); PG8_BAR; PG8_SCHED;
            PG8_LDA(At, 1, 1); PG8_STAGE(PG8_SB(1, 0), b3, voffB); PG8_STAGE(PG8_SB(1, 1), b3 + hstepB, voffB); PG8_STAGE(PG8_SA(1, 0), a3, voffA);
            PG8_WAIT_V(8); PG8_WAIT_L(0); PG8_BAR; PG8_MMA(1, 0, At, B0); PG8_MMA(1, 1, At, B1); PG8_BAR; PG8_SCHED;
            } else {
            PG8_LDB(B0, 0, 0); PG8_SCHED; PG8_LDA(At, 0, 0); PG8_STAGE(PG8_SA(1, 1), a1 + hstepA, voffA);
            PG8_WAIT_L(8); PG8_BAR; PG8_WAIT_L(0); PG8_MMA(0, 0, At, B0); PG8_BAR; PG8_SCHED;
            PG8_LDB(B1, 0, 1); PG8_STAGE(PG8_SB(0, 0), b2, voffB);
            PG8_BAR; PG8_WAIT_L(0); PG8_MMA(0, 1, At, B1); PG8_BAR;
            PG8_LDA(At, 0, 1); PG8_STAGE(PG8_SA(0, 0), a2, voffA);
            PG8_BAR; PG8_WAIT_L(0); PG8_MMA(1, 0, At, B0); PG8_BAR; PG8_SCHED;
            PG8_STAGE(PG8_SB(0, 1), b2 + hstepB, voffB);
            PG8_WAIT_V(6); PG8_BAR; PG8_MMA(1, 1, At, B1); PG8_BAR;
            PG8_LDB(B0, 1, 0); PG8_SCHED; PG8_LDA(At, 1, 0); PG8_STAGE(PG8_SA(0, 1), a2 + hstepA, voffA);
            PG8_WAIT_L(8); PG8_BAR; PG8_WAIT_L(0); PG8_MMA(0, 0, At, B0); PG8_BAR; PG8_SCHED;
            PG8_LDB(B1, 1, 1); PG8_STAGE(PG8_SB(1, 0), b3, voffB);
            PG8_BAR; PG8_WAIT_L(0); PG8_MMA(0, 1, At, B1); PG8_BAR;
            PG8_LDA(At, 1, 1); PG8_STAGE(PG8_SA(1, 0), a3, voffA);
            PG8_BAR; PG8_WAIT_L(0); PG8_MMA(1, 0, At, B0); PG8_BAR; PG8_SCHED;
            PG8_STAGE(PG8_SB(1, 1), b3 + hstepB, voffB);
            PG8_WAIT_V(6); PG8_BAR; PG8_MMA(1, 1, At, B1); PG8_BAR;
            }
        }
        if constexpr (ALIGN_EPI) { if (wr == 0) PG8_BAR; }
        if constexpr (!Epi::AFTER_DRAIN) { E(acc, cur, wr, wc, fr, fq); S.done(cur); }
        if (!has_next) break;
#pragma unroll
        for (int a = 0; a < 2; ++a)
#pragma unroll
            for (int b = 0; b < 2; ++b)
#pragma unroll
                for (int m = 0; m < 4; ++m)
#pragma unroll
                    for (int n = 0; n < 2; ++n) acc[a][b][m][n] = (f32x4){0.f, 0.f, 0.f, 0.f};
        cur = nxt; cA = nA; cB = nB; ++ui; if (cur.K) nt = cur.K / BK;
        if constexpr (ALIGN_EPI) { if (wr == 1) PG8_BAR; }
    }
    PG8_WAIT_V(0);
    if constexpr (!ALIGN_EPI) { if (wr == 0) PG8_BAR; }
    PG8_BAR;
    if constexpr (Epi::AFTER_DRAIN) { E.fused(acc, cur, wr, wc, fr, fq, lds, wid, lane); S.done(cur); }
#undef PG8_SA
#undef PG8_SB
#undef PG8_STAGE
#undef PG8_LDA
#undef PG8_LDB
#undef PG8_MMA
#undef PG8_WAIT_V
#undef PG8_WAIT_L
#undef PG8_BAR
#undef PG8_SCHED
}
}

DI void transpose_unit(const float* __restrict__ src, int ldsrc, int n_src0, int n_cnt, int kt, int nt, bf16_t* __restrict__ dst, long dst_ld,
                       int dst_n0, int dst_k0, int mode, unsigned char* smem, int tid512) {
  const int half = tid512 >> 8, tid = tid512 & 255;
  float* T = (float*)(smem + half * 20480);
  float* tab = (float*)(smem + 40960);
  const int k0 = kt * 64, nn0 = nt * 64;
  __syncthreads();
  if (tid512 < 64) tab[tid512] = __builtin_amdgcn_cosf((float)tid512 * (1.f / 64.f)) * 0.125f;
  {
    const int col = tid & 63, rq = tid >> 6;
#pragma unroll
    for (int i = 0; i < 16; ++i) {
      const int k = rq + 4 * i, n = nn0 + col;
      T[k * 65 + col] = (n < n_cnt) ? src[(long)(k0 + k) * ldsrc + n_src0 + n] : 0.f;
    }
  }
  __syncthreads();
  const int n = tid >> 2, q = tid & 3;
  float v[16];
  if (mode == 0) {
#pragma unroll
    for (int j = 0; j < 16; ++j) v[j] = T[(q * 16 + j) * 65 + n];
  } else {
#pragma unroll
    for (int j = 0; j < 16; ++j) v[j] = 0.f;
    const int sh = mode == 2 ? 48 : 0;
    for (int c = 0; c < 64; ++c) {
      const float w = tab[(c * n + sh) & 63];
#pragma unroll
      for (int j = 0; j < 16; ++j) v[j] += T[(q * 16 + j) * 65 + c] * w;
    }
  }
  if (nn0 + n < n_cnt) {
    u32x4 o0, o1;
    o0.x = pk_bf16(v[0], v[1]); o0.y = pk_bf16(v[2], v[3]); o0.z = pk_bf16(v[4], v[5]); o0.w = pk_bf16(v[6], v[7]);
    o1.x = pk_bf16(v[8], v[9]); o1.y = pk_bf16(v[10], v[11]); o1.z = pk_bf16(v[12], v[13]); o1.w = pk_bf16(v[14], v[15]);
    bf16_t* d = dst + (long)(dst_n0 + nn0 + n) * dst_ld + dst_k0 + k0 + q * 16;
    *(u32x4*)d = o0;
    *(u32x4*)(d + 8) = o1;
  }
}

DI void phase_prep_a(const Params& p, unsigned char* smem) {
  bf16_t* WinT = (bf16_t*)(p.ws + OFF_WINT);
  bf16_t* WgT = (bf16_t*)(p.ws + OFF_WGT);
  float* MODP = (float*)(p.ws + OFF_MODP);
  const int tid = hide_tid();
  const int half = tid >> 8;
  if (blockIdx.x == 0 && tid < 64) ((unsigned*)(p.ws + OFF_CTR))[tid] = 0u;
  const int N_MOD = 192, N_WIN = 2 * 16 * 14, N_WG = 2 * 16 * 24, N_FOLD = 2 * 16 * 4, N_ZERO = 2 * 96 * 128 / NTHR;
  const int total = N_MOD + N_WIN + N_WG + N_FOLD + N_ZERO;
  for (int u0 = blockIdx.x; u0 < total; u0 += gridDim.x) {
    int u = u0;
    if (u < N_MOD) {
      const int l = u / 96, rem = u % 96, cc = rem / 16, kc = rem % 16;
      float* s = (float*)smem;
      __syncthreads();
      if (tid < 192) {
        const int v = tid >> 6, k = tid & 63;
        const float cv = v == 0 ? p.c_ctx[kc * 64 + k] : p.c[(v - 1) * 1024 + kc * 64 + k];
        s[tid] = silu_f(cv);
      }
      __syncthreads();
      const int col = cc * 512 + tid;
      const float* w = p.w_mod + ((long)l * 1024 + kc * 64) * 3072 + col;
      float a0 = 0.f, a1 = 0.f, a2 = 0.f;
#pragma unroll 16
      for (int k = 0; k < 64; ++k) {
        const float wv = w[(long)k * 3072];
        a0 += s[k] * wv; a1 += s[64 + k] * wv; a2 += s[128 + k] * wv;
      }
      float* o = MODP + ((long)(kc * 2 + l) * 3) * 3072 + col;
      o[0] = a0; o[3072] = a1; o[6144] = a2;
      continue;
    }
    u -= N_MOD;
    if (u < N_WIN) {
      const int l = u / 224, rem = u % 224, kt = rem / 14, nt = 2 * (rem % 14) + half;
      transpose_unit(p.w_in + (long)l * 1024 * 5024, 5024, 256, 1696, kt, nt, WinT + (long)l * NEXTP * LDX, LDX, 512, 0, 0, smem, tid);
      continue;
    }
    u -= N_WIN;
    if (u < N_WG) {
      const int l = u / 384, rem = u % 384, kt = rem / 24, nt = 2 * (rem % 24) + half;
      transpose_unit(p.w_in + (long)l * 1024 * 5024, 5024, 1952, 3072, kt, nt, WgT + (long)l * 3072 * LDX, LDX, 0, 0, 0, smem, tid);
      continue;
    }
    u -= N_WG;
    if (u < N_FOLD) {
      const int l = u / 64, rem = u % 64, kt = rem / 4, g = rem & 3, part = half;
      transpose_unit(p.w_in + (long)l * 1024 * 5024, 5024, g * 64, 64, kt, 0, WinT + (long)l * NEXTP * LDX, LDX, part * 256 + g * 64, 0, 1 + part, smem, tid);
      continue;
    }
    u -= N_FOLD;
    {
      const long id = (long)u * NTHR + tid;
      const int l = (int)(id / (96 * 128)), rem = (int)(id % (96 * 128));
      u32x4 z = {0u, 0u, 0u, 0u};
      *(u32x4*)(WinT + (long)l * NEXTP * LDX + (long)(NEXT + rem / 128) * LDX + (long)(rem % 128) * 8) = z;
    }
  }
}

DI void phase_prep_b(const Params& p, unsigned char* smem) {
  const int tid = hide_tid();
  const int half = tid >> 8;
  float* tab = (float*)(smem + 65536);
  for (int i = tid; i < 4096; i += NTHR) tab[i] = __builtin_amdgcn_cosf((float)i * (1.f / 4096.f));
  __syncthreads();
  bf16_t* WqT = (bf16_t*)(p.ws + OFF_WQT);
  bf16_t* WkvT = (bf16_t*)(p.ws + OFF_WKVT);
  bf16_t* WbrT = (bf16_t*)(p.ws + OFF_WBRT);
  bf16_t* WoutT = (bf16_t*)(p.ws + OFF_WOUTT);
  bf16_t* PoolWt = (bf16_t*)(p.ws + OFF_POOLWT);
  const float* MODP = (const float*)(p.ws + OFF_MODP);
  float* MODF = (float*)(p.ws + OFF_MODF);
  float* ROPE = (float*)(p.ws + OFF_ROPE);
  bf16_t* Dp = (bf16_t*)(p.ws + OFF_DP);
  bf16_t* A1 = (bf16_t*)(p.ws + OFF_A1);
  bf16_t* D2 = (bf16_t*)(p.ws + OFF_D2);
  const int N_MODF = 36, N_WQ = 48, N_WKV = 32, N_BRA = 64, N_BRB = 64, N_BRC = 128, N_WOUT = 256, N_POOL = 256, N_ROPE = 256, N_DP = 32, N_A1 = 16, N_D2 = 512;
  const int total = N_MODF + N_WQ + N_WKV + N_BRA + N_BRB + N_BRC + N_WOUT + N_POOL + N_ROPE + N_DP + N_A1 + N_D2;
  for (int u0 = blockIdx.x; u0 < total; u0 += gridDim.x) {
    int u = u0;
    if (u < N_MODF) {
      const int idx = u * NTHR + tid;
      const int l = idx / 9216, rem = idx % 9216, col = rem % 3072;
      float a = p.b_mod[l * 3072 + col];
      for (int kc = 0; kc < 16; ++kc) a += MODP[(long)kc * 18432 + l * 9216 + rem];
      MODF[idx] = a;
      continue;
    }
    u -= N_MODF;
    if (u < N_WQ) { const int l = u / 24, rem = u % 24; transpose_unit(p.w_q_up + (long)l * 256 * 768, 768, 0, 768, rem / 6, 2 * (rem % 6) + half, WqT + (long)l * 768 * 256, 256, 0, 0, 0, smem, tid); continue; }
    u -= N_WQ;
    if (u < N_WKV) { const int l = u / 16, rem = u % 16; transpose_unit(p.w_kv_up + (long)l * 128 * 1024, 1024, 0, 1024, rem / 8, 2 * (rem % 8) + half, WkvT + (long)l * 1024 * 128, 128, 0, 0, 0, smem, tid); continue; }
    u -= N_WKV;
    if (u < N_BRA) { const int l = u / 32, rem = u % 32; transpose_unit(p.w_br_a + (long)l * 256 * 1024, 1024, 0, 1024, rem / 8, 2 * (rem % 8) + half, WbrT + (long)l * 1024 * 1024, 1024, 0, 0, 0, smem, tid); continue; }
    u -= N_BRA;
    if (u < N_BRB) { const int l = u / 32, rem = u % 32; transpose_unit(p.w_br_b + (long)l * 256 * 1024, 1024, 0, 1024, rem / 8, 2 * (rem % 8) + half, WbrT + (long)l * 1024 * 1024, 1024, 0, 256, 0, smem, tid); continue; }
    u -= N_BRB;
    if (u < N_BRC) { const int l = u / 64, rem = u % 64; transpose_unit(p.w_br_c + (long)l * 512 * 1024, 1024, 0, 1024, rem / 8, 2 * (rem % 8) + half, WbrT + (long)l * 1024 * 1024, 1024, 0, 512, 0, smem, tid); continue; }
    u -= N_BRC;
    if (u < N_WOUT) { const int l = u / 128, rem = u % 128; transpose_unit(p.w_out + (long)l * 1024 * 1024, 1024, 0, 1024, rem / 8, 2 * (rem % 8) + half, WoutT + (long)l * 1024 * 1024, 1024, 0, 0, 0, smem, tid); continue; }
    u -= N_WOUT;
    if (u < N_POOL) {
      const int idx = u * NTHR + tid;
      const int l = idx >> 16, n = (idx >> 8) & 255, k = idx & 255;
      float v = 0.f;
      if ((n >> 6) == (k >> 6)) v = p.pool_w[(((long)l * 4 + (n >> 6)) * 64 + (k & 63)) * 64 + (n & 63)];
      PoolWt[idx] = f2bf(v);
      continue;
    }
    u -= N_POOL;
    if (u < N_ROPE) {
      const int idx = u * NTHR + tid;
      const int pos = idx >> 5, d = idx & 31, f = d & 7;
      const float base = d < 16 ? (float)(pos >> 6) : (float)(pos & 63);
      const float freq = exp2f(-(float)f * (13.287712379549449f / 8.f));
      float rev = base * freq * 0.15915494309189535f;
      rev -= floorf(rev);
      ROPE[idx] = __builtin_amdgcn_cosf(rev);
      ROPE[4096 * 32 + idx] = __builtin_amdgcn_sinf(rev);
      continue;
    }
    u -= N_ROPE;
    if (u < N_DP) {
      const int id = u * NTHR + tid;
      const int lr = id >> 6, k0 = (id & 63) * 8, part = k0 >= 256, l0 = k0 & 255;
      float v[8];
#pragma unroll
      for (int j = 0; j < 8; ++j) { int n = ((lr * (l0 + j)) & 255) * 16; if (part) n = (n + 1024) & 4095; v[j] = tab[n] * (1.f / 16.f); }
      u32x4 o; o.x = pk_bf16(v[0], v[1]); o.y = pk_bf16(v[2], v[3]); o.z = pk_bf16(v[4], v[5]); o.w = pk_bf16(v[6], v[7]);
      *(u32x4*)(Dp + (long)lr * 512 + k0) = o;
      continue;
    }
    u -= N_DP;
    if (u < N_A1) {
      const int id = u * NTHR + tid;
      const int m = id >> 5, k0 = (id & 31) * 8, pm = (m >> 6) & 1, l1p = m & 63;
      float v[8];
#pragma unroll
      for (int j = 0; j < 8; ++j) {
        const int k = k0 + j, pk = (k >> 6) & 1, l1 = k & 63;
        float val = 0.f;
        if ((k >> 7) == (m >> 7)) {
          int n = ((l1 * l1p) & 63) * 64;
          if (pm != pk) n = (n + (pm == 0 ? 1024 : 3072)) & 4095;
          val = tab[n] * 0.125f;
        }
        v[j] = val;
      }
      u32x4 o; o.x = pk_bf16(v[0], v[1]); o.y = pk_bf16(v[2], v[3]); o.z = pk_bf16(v[4], v[5]); o.w = pk_bf16(v[6], v[7]);
      *(u32x4*)(A1 + (long)m * 256 + k0) = o;
      continue;
    }
    u -= N_A1;
    {
      const int id = u * NTHR + tid;
      const int row = id >> 6, k0 = (id & 63) * 8, qd = row >> 8, m = row & 255;
      const int lp = (4 * qd + (m >> 6)) + 64 * (m & 63);
      float v[8];
#pragma unroll
      for (int e = 0; e < 8; ++e) {
        const int k = k0 + e, blk = k >> 7, part = (k >> 6) & 1, l2 = k & 63;
        float val = 0.f;
        if (blk == (m >> 6)) {
          int n = (l2 * lp) & 4095;
          if (part) n = (n + 1024) & 4095;
          val = tab[n] * 0.125f;
        }
        v[e] = val;
      }
      u32x4 o; o.x = pk_bf16(v[0], v[1]); o.y = pk_bf16(v[2], v[3]); o.z = pk_bf16(v[4], v[5]); o.w = pk_bf16(v[6], v[7]);
      *(u32x4*)(D2 + (long)row * 512 + k0) = o;
    }
  }
}

DI void phase_xn(const Params& p, int l) {
  const int tid = hide_tid();
  const int wave = tid >> 6, lane = tid & 63;
  const float* ng = p.norm_g + l * 1024;
  const float* MODF = (const float*)(p.ws + OFF_MODF) + l * 9216;
  bf16_t* XN = (bf16_t*)(p.ws + OFF_XN);
  for (int row = blockIdx.x * NWAVE + wave; row < NTOK; row += gridDim.x * NWAVE) {
    const float* src = row < NPT ? p.x_prompt + (long)row * 1024 : p.x_sample + (long)(row - NPT) * 1024;
    const bf16_t* srcb = (const bf16_t*)p.out + (long)row * 1024;
    const float* md = MODF + tok_mod_idx(row) * 3072;
    f32x4 x[4];
    float ss = 0.f;
#pragma unroll
    for (int j = 0; j < 4; ++j) {
      if (l == 0) x[j] = *(const f32x4*)(src + j * 256 + lane * 4);
      else { const u32x2 hw = *(const u32x2*)(srcb + j * 256 + lane * 4); x[j] = (f32x4){bf_lo(hw.x), bf_hi(hw.x), bf_lo(hw.y), bf_hi(hw.y)}; }
      ss += x[j][0] * x[j][0] + x[j][1] * x[j][1] + x[j][2] * x[j][2] + x[j][3] * x[j][3];
    }
    ss = wave_sum(ss);
    const float r = rsqrtf(ss * (1.f / 1024.f) + EPS);
#pragma unroll
    for (int j = 0; j < 4; ++j) {
      const int c = j * 256 + lane * 4;
      const f32x4 g = *(const f32x4*)(ng + c), sh = *(const f32x4*)(md + c), sc = *(const f32x4*)(md + 1024 + c);
      float o[4];
#pragma unroll
      for (int e = 0; e < 4; ++e) o[e] = (x[j][e] * r) * g[e] * (1.f + sc[e]) + sh[e];
      u32x2 w; w.x = pk_bf16(o[0], o[1]); w.y = pk_bf16(o[2], o[3]);
      *(u32x2*)(XN + (long)row * LDX + c) = w;
    }
  }
}

struct EpiWin {
  static constexpr bool PERM = true, AFTER_DRAIN = false;
  bf16_t* P; bf16_t* LAT; bf16_t* ATp; bf16_t* Z;
  DI void operator()(const pg8::f32x4 (&acc)[2][2][4][2], const pg8::Unit& u, int wr, int wc, int fr_, int fq_) const {
    int fr = fr_, fq = fq_;
    asm volatile("" : "+v"(fr), "+v"(fq));
#pragma unroll
    for (int bj = 0; bj < 2; ++bj) {
      const int cb = u.pn * 256 + bj * 128 + wc * 32, c0 = cb + 8 * fq;
#pragma unroll
      for (int ai = 0; ai < 2; ++ai)
#pragma unroll
        for (int m = 0; m < 4; ++m) {
          const int row = u.pm * 256 + ai * 128 + wr * 64 + m * 16 + fr;
          const pg8::f32x4 v0 = acc[ai][bj][m][0], v1 = acc[ai][bj][m][1];
          if (cb < 512) {
            const int part = cb >> 8, cc = c0 & 255;
            bf16_t* dst;
            long cst;
            if (row < NPT) { const int b = row >> 8, pos = row & 255; dst = ATp + ((long)b * 256 + cc) * 512 + part * 256 + pos; cst = 512; }
            else { const int rs = row - NPT, b = rs >> 12, pos = rs & 4095; dst = Z + (((long)b * 256 + cc) * 2 + part) * 4096 + pos; cst = 8192; }
#pragma unroll
            for (int e = 0; e < 4; ++e) { dst[(long)e * cst] = f2bf(v0[e]); dst[(long)(4 + e) * cst] = f2bf(v1[e]); }
          } else if (cb >= 1280 && cb < 1696) {
            u32x4 w; w.x = pk_bf16(v0[0], v0[1]); w.y = pk_bf16(v0[2], v0[3]); w.z = pk_bf16(v1[0], v1[1]); w.w = pk_bf16(v1[2], v1[3]);
            *(u32x4*)(LAT + (long)row * LATW + (c0 - 1280)) = w;
          } else if (cb < NEXT) {
            const bool raw = (cb >= 768 && cb < 1024);
            const int pc = c0 < 1280 ? c0 - 512 : c0 - 928;
            float o[8];
#pragma unroll
            for (int e = 0; e < 4; ++e) { o[e] = raw ? v0[e] : silu_f(v0[e]); o[4 + e] = raw ? v1[e] : silu_f(v1[e]); }
            u32x4 w; w.x = pk_bf16(o[0], o[1]); w.y = pk_bf16(o[2], o[3]); w.z = pk_bf16(o[4], o[5]); w.w = pk_bf16(o[6], o[7]);
            *(u32x4*)(P + (long)row * PW + pc) = w;
          }
        }
    }
  }
};
DI void phase_win(const Params& p, int l, unsigned char* smem) {
  pg8::Gemm g{(const bf16_t*)(p.ws + OFF_XN), (const bf16_t*)(p.ws + OFF_WINT) + (long)l * NEXTP * LDX, NTOK, 2048, 1024, LDX, LDX};
  pg8::StaticOrder S;
  S.init(NTOK, 2048, gridDim.x, blockIdx.x);
  EpiWin E{(bf16_t*)(p.ws + OFF_P), (bf16_t*)(p.ws + OFF_LAT), (bf16_t*)(p.ws + OFF_ATP), (bf16_t*)(p.ws + OFF_Z)};
  __syncthreads();
  pg8::gemm_phase<EpiWin, pg8::StaticOrder, true, true>((PG8_LAS unsigned char*)smem, g, S, E);
}

struct TailOrder {
  int c, nwb;
  DI bool next(int i, pg8::Unit& u) const { const int L = i * nwb + c; if (L >= 64) return false; u.pm = L; u.pn = 8; return true; }
  DI void a_ready(const pg8::Unit&) const {}
  DI void done(const pg8::Unit&) const {}
};
DI void phase_win_tail(const Params& p, int l, unsigned char* smem, int nwb) {
  pg8::Gemm g{(const bf16_t*)(p.ws + OFF_XN), (const bf16_t*)(p.ws + OFF_WINT) + (long)l * NEXTP * LDX, NTOK, NEXTP, 1024, LDX, LDX};
  TailOrder S{(int)blockIdx.x, nwb};
  EpiWin E{(bf16_t*)(p.ws + OFF_P), (bf16_t*)(p.ws + OFF_LAT), (bf16_t*)(p.ws + OFF_ATP), (bf16_t*)(p.ws + OFF_Z)};
  __syncthreads();
  pg8::gemm_phase<EpiWin, TailOrder, true, true>((PG8_LAS unsigned char*)smem, g, S, E);
}

DI void phase_lat(const Params& p, int l, int first, int stride) {
  const int tid = hide_tid();
  const int wave = tid >> 6, lane = tid & 63;
  const bf16_t* LAT = (const bf16_t*)(p.ws + OFF_LAT);
  const float* ROPE = (const float*)(p.ws + OFF_ROPE);
  bf16_t* QN = (bf16_t*)(p.ws + OFF_QN);
  bf16_t* CKVB = (bf16_t*)(p.ws + OFF_CKVB);
  bf16_t* KR = (bf16_t*)(p.ws + OFF_KR);
  const float* qg = p.q_norm_g + l * 256;
  const float* kg = p.kv_norm_g + l * 128;
  constexpr int R = 4;
  const int rstep = stride * NWAVE;
  for (int row0 = first * NWAVE + wave; row0 < NROWS_KV; row0 += rstep * R) {
    f32x4 q[R]; f32x2 kv[R]; float kr[R], cs[R], sn[R];
#pragma unroll
    for (int i = 0; i < R; ++i) {
      const int row = min(row0 + i * rstep, NROWS_KV - 1);
      q[i] = (f32x4){0.f, 0.f, 0.f, 0.f}; cs[i] = 0.f; sn[i] = 0.f;
      if (row < NTOK) {
        const bf16_t* src = LAT + (long)row * LATW;
        { const u32x2 w = *(const u32x2*)(src + lane * 4); q[i] = (f32x4){bf_lo(w.x), bf_hi(w.x), bf_lo(w.y), bf_hi(w.y)}; }
        { const unsigned w = *(const unsigned*)(src + 256 + lane * 2); kv[i] = (f32x2){bf_lo(w), bf_hi(w)}; }
        kr[i] = lane < 32 ? bf2f_(src[384 + lane]) : 0.f;
        if (row >= NPT && lane < 32) { const int pos = (row - NPT) & 4095; cs[i] = ROPE[pos * 32 + lane]; sn[i] = ROPE[4096 * 32 + pos * 32 + lane]; }
      } else {
        const int cr = row - NTOK, b = cr >> 9, pp = cr & 511;
        kv[i] = *(const f32x2*)(p.cache_ckv + ((long)(b * 2 + l) * 512 + pp) * 128 + lane * 2);
        kr[i] = lane < 32 ? p.cache_krope[((long)(b * 2 + l) * 512 + pp) * 32 + lane] : 0.f;
      }
    }
    const f32x4 g = *(const f32x4*)(qg + lane * 4);
    const f32x2 g2 = *(const f32x2*)(kg + lane * 2);
#pragma unroll
    for (int i = 0; i < R; ++i) {
      const int row = row0 + i * rstep;
      if (row >= NROWS_KV) break;
      if (row < NTOK) {
        float ssq = wave_sum(q[i][0] * q[i][0] + q[i][1] * q[i][1] + q[i][2] * q[i][2] + q[i][3] * q[i][3]);
        float ssk = wave_sum(kv[i][0] * kv[i][0] + kv[i][1] * kv[i][1]);
        const float rq = rsqrtf(ssq * (1.f / 256.f) + EPS), rk = rsqrtf(ssk * (1.f / 128.f) + EPS);
        u32x2 w; w.x = pk_bf16(q[i][0] * rq * g[0], q[i][1] * rq * g[1]); w.y = pk_bf16(q[i][2] * rq * g[2], q[i][3] * rq * g[3]);
        *(u32x2*)(QN + (long)row * 256 + lane * 4) = w;
        const float c0 = kv[i][0] * rk * g2[0], c1 = kv[i][1] * rk * g2[1];
        *(unsigned*)(CKVB + (long)row * 128 + lane * 2) = pk_bf16(c0, c1);
        if (row < NPT) {
          const int b = row >> 8, s = row & 255;
          const long o = ((long)(b * 2 + l) * 256 + s);
          f32x2 cv = {c0, c1};
          *(f32x2*)(p.out + OUT_CKV + o * 128 + lane * 2) = cv;
          if (lane < 32) {
            p.out[OUT_KR + o * 32 + lane] = kr[i];
            KR[(long)row * 32 + lane] = f2bf(kr[i]);
          }
        } else {
          const int rs = row - NPT, b = rs >> 12, pos = rs & 4095;
          const float partner = __shfl_xor(kr[i], 8);
          if (lane < 32) {
            const float rx = (lane & 8) ? partner : -partner;
            KR[((long)NPT + (long)b * LKS + pos) * 32 + lane] = f2bf(kr[i] * cs[i] + rx * sn[i]);
          }
        }
      } else {
        const int cr = row - NTOK, b = cr >> 9, pp = cr & 511;
        *(unsigned*)(CKVB + (long)row * 128 + lane * 2) = pk_bf16(kv[i][0], kv[i][1]);
        if (lane < 32) KR[((long)NPT + (long)b * LKS + 4096 + pp) * 32 + lane] = f2bf(kr[i]);
      }
    }
  }
}

template <int W> DI void pool_item(const bf16_t* __restrict__ P, bf16_t* __restrict__ PB, int t, int ch) {
  constexpr int left = W / 2, right = W - 1 - left;
  int s0, L;
  if (t < NPT) { s0 = t & ~255; L = 256; } else { s0 = NPT + ((t - NPT) & ~4095); L = 4096; }
  const int tt = t - s0;
  u32x4 v[W];
#pragma unroll
  for (int j = 0; j < W; ++j) {
    int idx = tt - left + j;
    idx = idx < 0 ? 0 : (idx > L - 1 ? L - 1 : idx);
    v[j] = *(const u32x4*)(P + (long)(s0 + idx) * PW + PC_BIN + ch * 8);
  }
  float sum[8];
#pragma unroll
  for (int e = 0; e < 8; ++e) sum[e] = 0.f;
#pragma unroll
  for (int j = 0; j < W; ++j) {
    const int idx = tt - left + j;
    const float m = (idx >= 0 && idx < L) ? 1.f : 0.f;
    sum[0] += m * bf_lo(v[j].x); sum[1] += m * bf_hi(v[j].x); sum[2] += m * bf_lo(v[j].y); sum[3] += m * bf_hi(v[j].y);
    sum[4] += m * bf_lo(v[j].z); sum[5] += m * bf_hi(v[j].z); sum[6] += m * bf_lo(v[j].w); sum[7] += m * bf_hi(v[j].w);
  }
  const int lo = max(tt - left, 0), hi = min(tt + right, L - 1);
  const u32x4 c = v[left];
  const float inv = 1.f / (float)(hi - lo + 1);
  u32x4 o;
  o.x = pk_bf16(sum[0] * inv - bf_lo(c.x), sum[1] * inv - bf_hi(c.x));
  o.y = pk_bf16(sum[2] * inv - bf_lo(c.y), sum[3] * inv - bf_hi(c.y));
  o.z = pk_bf16(sum[4] * inv - bf_lo(c.z), sum[5] * inv - bf_hi(c.z));
  o.w = pk_bf16(sum[6] * inv - bf_lo(c.w), sum[7] * inv - bf_hi(c.w));
  *(u32x4*)(PB + (long)t * 256 + ch * 8) = o;
}
DI void phase_up(const Params& p, int l, unsigned char* smem) {
  const int tid_outer = hide_tid();
  const bf16_t* QN = (const bf16_t*)(p.ws + OFF_QN);
  const bf16_t* CKVB = (const bf16_t*)(p.ws + OFF_CKVB);
  const bf16_t* WqT = (const bf16_t*)(p.ws + OFF_WQT) + (long)l * 768 * 256;
  const bf16_t* WkvT = (const bf16_t*)(p.ws + OFF_WKVT) + (long)l * 1024 * 128;
  const float* ROPE = (const float*)(p.ws + OFF_ROPE);
  bf16_t* Q = (bf16_t*)(p.ws + OFF_Q);
  bf16_t* Kp = (bf16_t*)(p.ws + OFF_KP);
  bf16_t* Ks = (bf16_t*)(p.ws + OFF_KS);
  bf16_t* Vtp = (bf16_t*)(p.ws + OFF_VTP);
  bf16_t* Vts = (bf16_t*)(p.ws + OFF_VTS);
  const bf16_t* P = (const bf16_t*)(p.ws + OFF_P);
  bf16_t* PB = (bf16_t*)(p.ws + OFF_PB);
  const int N_Q = 64 * 3, N_KV = 68 * 4;
  const int total = N_Q + N_KV;
  const int tid0 = tid_outer;
  for (int u0 = virt_block(); u0 < total; u0 += gridDim.x) {
    int tid = tid0;
    asm volatile("" : "+v"(tid));
    int u = u0;
    if (u < N_Q) {
      int mt, nt;
      tile_decode(u, 3, mt, nt);
      f32x16 acc[4][2];
      acc_zero(acc);
      gemm_main(tid, QN + (long)mt * 256 * 256, 256, WqT + (long)nt * 256 * 256, 256, 256, acc, smem);
      epi_blocks(tid, acc, mt * 256, nt * 256, [&](int row, int cb, int hh, const f32x16& a) {
        const int head = cb / 96, j0 = cb % 96;
        bf16_t* d;
        int pos = 0;
        const bool samp = row >= NPT;
        if (!samp) { const int b = row >> 8; pos = row & 255; d = Q + ((long)(b * 8 + head) * 256 + pos) * 96 + j0 + 4 * hh; }
        else { const int rs = row - NPT, b = rs >> 12; pos = rs & 4095; d = Q + (long)NPT * 768 + ((long)(b * 8 + head) * 4096 + pos) * 96 + j0 + 4 * hh; }
        float v[16];
#pragma unroll
        for (int i = 0; i < 16; ++i) v[i] = a[i];
        if (samp && j0 == 64) {
#pragma unroll
          for (int gp = 0; gp < 2; ++gp) {
            const f32x4 cs = *(const f32x4*)(ROPE + pos * 32 + 16 * gp + 4 * hh);
            const f32x4 sn = *(const f32x4*)(ROPE + 4096 * 32 + pos * 32 + 16 * gp + 4 * hh);
#pragma unroll
            for (int e = 0; e < 4; ++e) {
              const float x0 = a[8 * gp + e], x1 = a[8 * gp + 4 + e];
              v[8 * gp + e] = x0 * cs[e] - x1 * sn[e];
              v[8 * gp + 4 + e] = x1 * cs[e] + x0 * sn[e];
            }
          }
        }
#pragma unroll
        for (int g = 0; g < 4; ++g) {
          u32x2 w; w.x = pk_bf16(v[4 * g] * QSCALE, v[4 * g + 1] * QSCALE); w.y = pk_bf16(v[4 * g + 2] * QSCALE, v[4 * g + 3] * QSCALE);
          *(u32x2*)(d + 8 * g) = w;
        }
      });
      continue;
    }
    u -= N_Q;
    if (u < N_KV) {
      const int mt = u >> 2, nt = u & 3;
      f32x16 acc[4][2];
      acc_zero(acc);
      gemm_main(tid, CKVB + (long)mt * 256 * 128, 128, WkvT + (long)nt * 256 * 128, 128, 128, acc, smem);
      epi_blocks(tid, acc, mt * 256, nt * 256, [&](int row, int cb, int hh, const f32x16& a) {
        const int head = cb >> 7, j0 = cb & 127;
        const bool samp = row >= NPT;
        int b, pos;
        if (!samp) { b = row >> 8; pos = row & 255; }
        else if (row < NTOK) { const int rs = row - NPT; b = rs >> 12; pos = rs & 4095; }
        else { const int cr = row - NTOK; b = cr >> 9; pos = 4096 + (cr & 511); }
        const int Lk = samp ? LKS : 256;
        const size_t kofs = samp ? OFF_KS : OFF_KP, vofs = samp ? OFF_VTS : OFF_VTP;
        bf16_t* kbase = (bf16_t*)(p.ws + kofs) + (long)(b * 8 + head) * Lk * 64;
        bf16_t* vbase = (bf16_t*)(p.ws + vofs) + (long)(b * 8 + head) * 64 * Lk;
        if (j0 < 64) {
          bf16_t* d = kbase + (long)pos * 64 + j0 + 4 * hh;
#pragma unroll
          for (int g = 0; g < 4; ++g) { u32x2 w; w.x = pk_bf16(a[4 * g], a[4 * g + 1]); w.y = pk_bf16(a[4 * g + 2], a[4 * g + 3]); *(u32x2*)(d + 8 * g) = w; }
        } else {
          bf16_t* d = vbase + (long)(j0 - 64 + 4 * hh) * Lk + pos;
#pragma unroll
          for (int i = 0; i < 16; ++i) d[(long)((i & 3) + 8 * (i >> 2)) * Lk] = f2bf(a[i]);
        }
      });
      continue;
    }
  }
}

DI void phase_aux(const Params& p, int l, unsigned char* smem, int first, int stride) {
  const int tid_outer = hide_tid();
  const bf16_t* P = (const bf16_t*)(p.ws + OFF_P);
  bf16_t* PB = (bf16_t*)(p.ws + OFF_PB);
  const int N_F1 = 128, N_POOL = 1024;
  const int total = N_F1 + N_POOL;
  const int tid0 = tid_outer;
  for (int u0 = first; u0 < total; u0 += stride) {
    int tid = tid0;
    asm volatile("" : "+v"(tid));
    int u = u0;
    if (u < N_F1) {
      const int b = u >> 6, cg = u & 63;
      const bf16_t* A1 = (const bf16_t*)(p.ws + OFF_A1);
      const bf16_t* Zs = (const bf16_t*)(p.ws + OFF_Z) + ((long)(b * 256 + 4 * cg) * 2) * 4096;
      bf16_t* Y1 = (bf16_t*)(p.ws + OFF_Y1) + ((long)(b * 256 + 4 * cg) * 64) * 128;
      f32x16 acc[4][2];
      acc_zero(acc);
      __syncthreads();
      gemm_dma_b(tid, A1, 256, 0, smem);
      gemm_dma_b(tid, A1, 256, 64, smem + GM_STAGE);
#pragma unroll
      for (int part = 0; part < 2; ++part)
#pragma unroll
        for (int it = 0; it < 4; ++it) {
          const int item = tid + NTHR * it, l2c = item & 7, l1 = (item >> 3) & 63, cl = item >> 9;
          const u32x4 v = *(const u32x4*)(Zs + ((long)(cl * 2 + part)) * 4096 + l1 * 64 + l2c * 8);
          const unsigned w[4] = {v.x, v.y, v.z, v.w};
          unsigned char* st = smem + part * GM_STAGE;
#pragma unroll
          for (int e = 0; e < 8; ++e) {
            const int m = cl * 64 + l2c * 8 + e;
            const unsigned hv = (e & 1) ? (w[e >> 1] >> 16) : (w[e >> 1] & 0xffffu);
            *(bf16_t*)(st + m * 128 + (((l1 >> 3) ^ ((m >> 1) & 7)) << 4) + (l1 & 7) * 2) = (bf16_t)hv;
          }
        }
      asm volatile("s_waitcnt vmcnt(0)" ::: "memory");
      __syncthreads();
      gemm_compute(tid, smem, acc);
      gemm_compute(tid, smem + GM_STAGE, acc);
      __syncthreads();
      epi_blocks(tid, acc, 0, 0, [&](int row, int cb, int hh, const f32x16& a) {
        if (cb < 128) {
          bf16_t* d = Y1 + ((long)(row >> 6) * 64) * 128 + (row & 63);
#pragma unroll
          for (int i = 0; i < 16; ++i) { const int n = cb + (i & 3) + 8 * (i >> 2) + 4 * hh; d[(long)(n & 63) * 128 + (n >> 6) * 64] = f2bf(a[i]); }
        }
      });
      continue;
    }
    u -= N_F1;
    {
      const int id = u * NTHR + tid;
      const int gi = (id >> 6) & 3, t = ((id >> 8) << 3) | ((id >> 3) & 7), ch = gi * 8 + (id & 7);
      if (gi == 0) pool_item<2>(P, PB, t, ch);
      else if (gi == 1) pool_item<4>(P, PB, t, ch);
      else if (gi == 2) pool_item<8>(P, PB, t, ch);
      else pool_item<16>(P, PB, t, ch);
    }
  }
}

constexpr int ATT_KSTR = 208, ATT_VSTR = 144, ATT_VOFF = 64 * ATT_KSTR, ATT_STAGE = ATT_VOFF + 64 * ATT_VSTR;
DI void attn_load_g(int tid, const bf16_t* __restrict__ Kn, const bf16_t* __restrict__ Kr, const bf16_t* __restrict__ Vt, int Lk, int kt, u32x4 (&rk)[2], u32x4& rv) {
  rk[0] = *(const u32x4*)(Kn + (long)kt * 64 * 64 + (long)tid * 8);
  if (tid < 256) rk[1] = *(const u32x4*)(Kr + (long)kt * 64 * 32 + (long)tid * 8);
  { const int dv = tid >> 3, part = tid & 7; rv = *(const u32x4*)(Vt + (long)dv * Lk + kt * 64 + part * 8); }
}
DI void attn_store_l(int tid, unsigned char* st, const u32x4 (&rk)[2], const u32x4& rv) {
  { const int key = tid >> 3, part = tid & 7; *(u32x4*)(st + key * ATT_KSTR + part * 16) = rk[0]; }
  if (tid < 256) { const int key = tid >> 2, part = 8 + (tid & 3); *(u32x4*)(st + key * ATT_KSTR + part * 16) = rk[1]; }
  {
    const int dv = tid >> 3, part = tid & 7;
    unsigned char* d = st + ATT_VOFF + dv * ATT_VSTR + ((part >> 1) * 16 + (part & 1) * 4) * 2;
    u32x2 lo = {rv.x, rv.y}, hi = {rv.z, rv.w};
    *(u32x2*)d = lo;
    *(u32x2*)(d + 16) = hi;
  }
}
DI void attn_unit(const Params& p, int kind, int idx, unsigned char* smem, int tid) {
  int Lq, Lk, b, h, qb, tokbase;
  const bf16_t *Q, *Kn, *Kr, *Vt;
  if (kind) {
    Lq = 4096; Lk = LKS; qb = idx & 15; h = (idx >> 4) & 7; b = idx >> 7; tokbase = NPT + b * 4096;
    Q = (const bf16_t*)(p.ws + OFF_Q) + (long)NPT * 768 + ((long)(b * 8 + h) * Lq + qb * 256) * 96;
    Kn = (const bf16_t*)(p.ws + OFF_KS) + (long)(b * 8 + h) * Lk * 64;
    Kr = (const bf16_t*)(p.ws + OFF_KR) + ((long)NPT + (long)b * LKS) * 32;
    Vt = (const bf16_t*)(p.ws + OFF_VTS) + (long)(b * 8 + h) * 64 * Lk;
  } else {
    Lq = 256; Lk = 256; qb = 0; h = idx & 7; b = idx >> 3; tokbase = b * 256;
    Q = (const bf16_t*)(p.ws + OFF_Q) + ((long)(b * 8 + h) * Lq) * 96;
    Kn = (const bf16_t*)(p.ws + OFF_KP) + (long)(b * 8 + h) * Lk * 64;
    Kr = (const bf16_t*)(p.ws + OFF_KR) + (long)b * 256 * 32;
    Vt = (const bf16_t*)(p.ws + OFF_VTP) + (long)(b * 8 + h) * 64 * Lk;
  }
  const int wave = tid >> 6, lane = tid & 63, r = lane & 31, hh = lane >> 5;
  bf16x8 qf[6];
#pragma unroll
  for (int s = 0; s < 6; ++s) qf[s] = *(const bf16x8*)(Q + (long)(wave * 32 + r) * 96 + 16 * s + 8 * hh);
  f32x16 O[2];
#pragma unroll
  for (int i = 0; i < 16; ++i) { O[0][i] = 0.f; O[1][i] = 0.f; }
  float m = 0.f, lsum = 0.f;
  u32x4 rk0[2], rv0, rk1[2], rv1;
  const int nkt = Lk >> 6;
  attn_load_g(tid, Kn, Kr, Vt, Lk, 0, rk0, rv0);
  attn_load_g(tid, Kn, Kr, Vt, Lk, 1, rk1, rv1);
  attn_store_l(tid, smem, rk0, rv0);
  __syncthreads();
  auto tile = [&](const unsigned char* st) {
    f32x16 S[2];
    const float negm = -m;
#pragma unroll
    for (int kb = 0; kb < 2; ++kb) {
#pragma unroll
      for (int i = 0; i < 16; ++i) S[kb][i] = negm;
#pragma unroll
      for (int s = 0; s < 6; ++s) {
        const bf16x8 kf = *(const bf16x8*)(st + (kb * 32 + r) * ATT_KSTR + (16 * s + 8 * hh) * 2);
        S[kb] = __builtin_amdgcn_mfma_f32_32x32x16_bf16(kf, qf[s], S[kb], 0, 0, 0);
      }
    }
    float mx = fmaxf(fmaxf(S[0][0], S[0][1]), S[0][2]);
#pragma unroll
    for (int i = 3; i < 15; i += 2) mx = fmaxf(fmaxf(mx, S[0][i]), S[0][i + 1]);
    mx = fmaxf(mx, S[0][15]);
#pragma unroll
    for (int i = 0; i < 16; i += 2) mx = fmaxf(fmaxf(mx, S[1][i]), S[1][i + 1]);
    mx = fmaxf(mx, __shfl_xor(mx, 32));
    if (__builtin_amdgcn_ballot_w64(mx > 0.f) != 0ull) {
      const float delta = fmaxf(mx, 0.f);
      const float alpha = __builtin_amdgcn_exp2f(-delta);
      m += delta;
      lsum *= alpha;
#pragma unroll
      for (int i = 0; i < 16; ++i) { O[0][i] *= alpha; O[1][i] *= alpha; S[0][i] -= delta; S[1][i] -= delta; }
    }
    float ps = 0.f;
#pragma unroll
    for (int kb = 0; kb < 2; ++kb)
#pragma unroll
      for (int i = 0; i < 16; ++i) { const float e = __builtin_amdgcn_exp2f(S[kb][i]); S[kb][i] = e; ps += e; }
    lsum += ps;
#pragma unroll
    for (int kb = 0; kb < 2; ++kb)
#pragma unroll
      for (int s = 0; s < 2; ++s) {
        u32x4 pw;
        pw.x = pk_bf16(S[kb][8 * s + 0], S[kb][8 * s + 1]); pw.y = pk_bf16(S[kb][8 * s + 2], S[kb][8 * s + 3]);
        pw.z = pk_bf16(S[kb][8 * s + 4], S[kb][8 * s + 5]); pw.w = pk_bf16(S[kb][8 * s + 6], S[kb][8 * s + 7]);
        const bf16x8 pf = __builtin_bit_cast(bf16x8, pw);
#pragma unroll
        for (int dvb = 0; dvb < 2; ++dvb) {
          const bf16x8 vf = *(const bf16x8*)(st + ATT_VOFF + (dvb * 32 + r) * ATT_VSTR + (kb * 32 + 16 * s + 8 * hh) * 2);
          O[dvb] = __builtin_amdgcn_mfma_f32_32x32x16_bf16(vf, pf, O[dvb], 0, 0, 0);
        }
      }
  };
  for (int kt = 0; kt < nkt; kt += 2) {
    if (kt + 2 < nkt) attn_load_g(tid, Kn, Kr, Vt, Lk, kt + 2, rk0, rv0);
    __builtin_amdgcn_sched_barrier(0);
    tile(smem);
    __builtin_amdgcn_sched_barrier(0);
    attn_store_l(tid, smem + ATT_STAGE, rk1, rv1);
    __syncthreads();
    if (kt + 3 < nkt) attn_load_g(tid, Kn, Kr, Vt, Lk, kt + 3, rk1, rv1);
    __builtin_amdgcn_sched_barrier(0);
    tile(smem + ATT_STAGE);
    __builtin_amdgcn_sched_barrier(0);
    if (kt + 2 < nkt) attn_store_l(tid, smem, rk0, rv0);
    __syncthreads();
  }
  lsum += __shfl_xor(lsum, 32);
  const float inv = 1.f / lsum;
  const int t = tokbase + qb * 256 + wave * 32 + r;
  const bf16_t* gate = (const bf16_t*)(p.ws + OFF_P) + (long)t * PW + PC_CZ + h * 64 + 4 * hh;
  bf16_t* dst = (bf16_t*)(p.ws + OFF_X) + (long)t * 1024 + 512 + h * 64 + 4 * hh;
#pragma unroll
  for (int dvb = 0; dvb < 2; ++dvb)
#pragma unroll
    for (int g = 0; g < 4; ++g) {
      const u32x2 gv = *(const u32x2*)(gate + dvb * 32 + 8 * g);
      u32x2 w;
      w.x = pk_bf16(O[dvb][4 * g] * inv * bf_lo(gv.x), O[dvb][4 * g + 1] * inv * bf_hi(gv.x));
      w.y = pk_bf16(O[dvb][4 * g + 2] * inv * bf_lo(gv.y), O[dvb][4 * g + 3] * inv * bf_hi(gv.y));
      *(u32x2*)(dst + dvb * 32 + 8 * g) = w;
    }
}

DI void phase_mix(const Params& p, int l, unsigned char* smem) {
  const int tid_outer = hide_tid();
  unsigned* ctr = (unsigned*)(p.ws + OFF_CTR) + l;
  __shared__ int s_unit;
  const bf16_t* P = (const bf16_t*)(p.ws + OFF_P);
  bf16_t* X = (bf16_t*)(p.ws + OFF_X);
  const int total = 640;
  int hu = virt_block();
  const int tid0 = tid_outer;
  while (true) {
    int tid = tid0;
    asm volatile("" : "+v"(tid));
    int u;
    if (hu < 256) { u = hu; hu += gridDim.x; }
    else {
      __syncthreads();
      if (tid == 0) s_unit = 256 + (int)atomicAdd(ctr, 1u);
      __syncthreads();
      u = s_unit;
      if (u >= total) break;
      u = u < 256 + 128 ? u + 256 : u - 128;
    }
    if (u < 512) {
      const int kind = u < 256 ? 1 : 0;
      attn_unit(p, kind, kind ? u : u - 256, smem, tid);
      continue;
    }
    const bf16_t *A, *Bt;
    long lda, ldb;
    int K, tokbase, fq = -1, gcol, xcol;
    const float* sc = nullptr;
    if (u < 544) {
      const int v = u - 512, b = v >> 4;
      fq = v & 15; lda = 8192; ldb = 512; K = 512; tokbase = NPT + b * 4096 + 4 * fq; gcol = PC_AZ; xcol = 0;
      A = (const bf16_t*)(p.ws + OFF_Y1) + (((long)b * 256) * 64 + 4 * fq) * 128;
      Bt = (const bf16_t*)(p.ws + OFF_D2) + (long)fq * 256 * 512;
    } else if (u < 576) {
      const int b = u - 544;
      lda = 512; ldb = 512; K = 512; tokbase = b * 256; gcol = PC_AZ; xcol = 0;
      A = (const bf16_t*)(p.ws + OFF_DP);
      Bt = (const bf16_t*)(p.ws + OFF_ATP) + (long)b * 256 * 512;
    } else {
      const int mt = u - 576;
      lda = 256; ldb = 256; K = 256; tokbase = mt * 256; gcol = PC_BZ; xcol = 256;
      A = (const bf16_t*)(p.ws + OFF_PB) + (long)mt * 256 * 256;
      Bt = (const bf16_t*)(p.ws + OFF_POOLWT) + (long)l * 65536;
      sc = p.pool_scale + l * 256;
    }
    f32x16 acc[4][2];
    acc_zero(acc);
    gemm_main(tid, A, lda, Bt, ldb, K, acc, smem);
    if (fq >= 0) {
      epi_blocks(tid, acc, 0, 0, [&](int row, int cb, int hh, const f32x16& a) {
#pragma unroll
        for (int i = 0; i < 16; ++i) {
          const int n = cb + (i & 3) + 8 * (i >> 2) + 4 * hh;
          const long t = tokbase + (n >> 6) + 64 * (n & 63);
          X[t * 1024 + row] = f2bf(a[i] * bf2f_(P[t * PW + PC_AZ + row]));
          asm volatile("" ::: "memory");
        }
      });
      continue;
    }
    epi_blocks(tid, acc, 0, 0, [&](int row, int cb, int hh, const f32x16& a) {
      const long t = (long)tokbase + row;
      const bf16_t* gp = P + t * PW + gcol + cb + 4 * hh;
      bf16_t* d = X + t * 1024 + xcol + cb + 4 * hh;
#pragma unroll
      for (int g = 0; g < 4; ++g) {
        const u32x2 gv = *(const u32x2*)(gp + 8 * g);
        f32x4 s4 = {1.f, 1.f, 1.f, 1.f};
        if (sc) s4 = *(const f32x4*)(sc + cb + 4 * hh + 8 * g);
        u32x2 w;
        w.x = pk_bf16(a[4 * g] * s4[0] * bf_lo(gv.x), a[4 * g + 1] * s4[1] * bf_hi(gv.x));
        w.y = pk_bf16(a[4 * g + 2] * s4[2] * bf_lo(gv.y), a[4 * g + 3] * s4[3] * bf_hi(gv.y));
        *(u32x2*)(d + 8 * g) = w;
      }
    });
  }
}

DI size_t gate_image_ofs(int seg) { return seg == 0 ? OFF_G : (seg == 1 ? OFF_P : OFF_KS); }
struct GateOrder {
  int pm, pn;
  DI bool next(int i, pg8::Unit& u) const { if (i >= 3) return false; u.pm = pm; u.pn = i * 4 + pn; return true; }
  DI void a_ready(const pg8::Unit&) const {}
  DI void done(const pg8::Unit&) const {}
};
struct EpiGate {
  static constexpr bool PERM = true, AFTER_DRAIN = false;
  unsigned char* ws;
  DI void operator()(const pg8::f32x4 (&acc)[2][2][4][2], const pg8::Unit& u, int wr, int wc, int fr_, int fq_) const {
    int fr = fr_, fq = fq_;
    asm volatile("" : "+v"(fr), "+v"(fq));
    bf16_t* G = (bf16_t*)(ws + gate_image_ofs(u.pn >> 2));
    const int pnl = u.pn & 3;
#pragma unroll
    for (int bj = 0; bj < 2; ++bj)
#pragma unroll
      for (int ai = 0; ai < 2; ++ai)
#pragma unroll
        for (int m = 0; m < 4; ++m) {
          const int row = u.pm * 256 + ai * 128 + wr * 64 + m * 16 + fr, c0 = pnl * 256 + bj * 128 + wc * 32 + 8 * fq;
          const pg8::f32x4 v0 = acc[ai][bj][m][0], v1 = acc[ai][bj][m][1];
          u32x4 w; w.x = pk_bf16(sigmoid_f(v0[0]), sigmoid_f(v0[1])); w.y = pk_bf16(sigmoid_f(v0[2]), sigmoid_f(v0[3]));
          w.z = pk_bf16(sigmoid_f(v1[0]), sigmoid_f(v1[1])); w.w = pk_bf16(sigmoid_f(v1[2]), sigmoid_f(v1[3]));
          (void)row; (void)c0;
          *(u32x4*)(G + ((long)((u.pm * 4 + pnl) * 16 + (bj * 2 + ai) * 4 + m) * 512 + ((wr * 4 + wc) * 64 + fq * 16 + fr)) * 8) = w;
        }
  }
};
struct EpiBranch {
  static constexpr bool PERM = true, AFTER_DRAIN = false;
  unsigned char* ws; bf16_t* Y;
  DI void operator()(const pg8::f32x4 (&acc)[2][2][4][2], const pg8::Unit& u, int wr, int wc, int fr_, int fq_) const {
    int fr = fr_, fq = fq_;
    asm volatile("" : "+v"(fr), "+v"(fq));
    const int seg = u.koff == 0 ? 0 : (u.koff == 256 ? 1 : 2);
    const bf16_t* G = (const bf16_t*)(ws + gate_image_ofs(seg));
    bf16_t* YT = (bf16_t*)(ws + gate_image_ofs(0));
#pragma unroll
    for (int bj = 0; bj < 2; ++bj)
#pragma unroll
      for (int ai = 0; ai < 2; ++ai)
#pragma unroll
        for (int m = 0; m < 4; ++m) {
          const int row = u.pm * 256 + ai * 128 + wr * 64 + m * 16 + fr, c0 = u.pn * 256 + bj * 128 + wc * 32 + 8 * fq;
          const pg8::f32x4 v0 = acc[ai][bj][m][0], v1 = acc[ai][bj][m][1];
          const long tm = ((long)((u.pm * 4 + u.pn) * 16 + (bj * 2 + ai) * 4 + m) * 512 + ((wr * 4 + wc) * 64 + fq * 16 + fr)) * 8;
          const u32x4 gv = *(const u32x4*)(G + tm);
          u32x4 yv = {0u, 0u, 0u, 0u};
          if (seg > 0) yv = *(const u32x4*)(YT + tm);
          u32x4 w;
          w.x = pk_bf16(bf_lo(yv.x) + v0[0] * bf_lo(gv.x), bf_hi(yv.x) + v0[1] * bf_hi(gv.x));
          w.y = pk_bf16(bf_lo(yv.y) + v0[2] * bf_lo(gv.y), bf_hi(yv.y) + v0[3] * bf_hi(gv.y));
          w.z = pk_bf16(bf_lo(yv.z) + v1[0] * bf_lo(gv.z), bf_hi(yv.z) + v1[1] * bf_hi(gv.z));
          w.w = pk_bf16(bf_lo(yv.w) + v1[2] * bf_lo(gv.w), bf_hi(yv.w) + v1[3] * bf_hi(gv.w));
          if (seg < 2) *(u32x4*)(YT + tm) = w;
          else *(u32x4*)(Y + (long)row * 1024 + c0) = w;
        }
  }
};
DI void phase_merge(const Params& p, int l, unsigned char* smem) {
  const bf16_t* X = (const bf16_t*)(p.ws + OFF_X);
  const bf16_t* XN = (const bf16_t*)(p.ws + OFF_XN);
  const bf16_t* WbrT = (const bf16_t*)(p.ws + OFF_WBRT) + (long)l * 1024 * 1024;
  const bf16_t* WgT = (const bf16_t*)(p.ws + OFF_WGT) + (long)l * 3072 * LDX;
  bf16_t* Y = (bf16_t*)(p.ws + OFF_Y);
  pg8::StaticOrder S;
  S.init(NTOK, 1024, gridDim.x, blockIdx.x);
  pg8::Unit tile;
#pragma unroll 1
  for (int ti = 0; S.next(ti, tile); ++ti) {
    {
      pg8::Gemm g{XN, WgT, NTOK, 3072, 1024, LDX, LDX};
      GateOrder O{tile.pm, tile.pn};
      EpiGate E{p.ws};
      __syncthreads();
      pg8::gemm_phase<EpiGate, GateOrder, true, true>((PG8_LAS unsigned char*)smem, g, O, E);
    }
    {
      pg8::Gemm g{X, WbrT, NTOK, 1024, 256, 1024, 1024};
      struct BranchOrder {
        int pm, pn;
        DI bool next(int i, pg8::Unit& u) const { if (i >= 3) return false; u.pm = pm; u.pn = pn; u.koff = i * 256; u.K = i == 2 ? 512 : 256; return true; }
        DI void a_ready(const pg8::Unit&) const {}
        DI void done(const pg8::Unit&) const {}
      } O{tile.pm, tile.pn};
      EpiBranch E{p.ws, Y};
      __syncthreads();
      pg8::gemm_phase<EpiBranch, BranchOrder, true, true>((PG8_LAS unsigned char*)smem, g, O, E);
    }
  }
}

struct EpiWout {
  static constexpr bool PERM = true, AFTER_DRAIN = false;
  const float* x_prompt; const float* x_sample; const bf16_t* hb_in; bf16_t* hb_out; const float* MODF; int l;
  DI void operator()(const pg8::f32x4 (&acc)[2][2][4][2], const pg8::Unit& u, int wr, int wc, int fr_, int fq_) const {
    int fr = fr_, fq = fq_;
    asm volatile("" : "+v"(fr), "+v"(fq));
#pragma unroll
    for (int bj = 0; bj < 2; ++bj)
#pragma unroll
      for (int ai = 0; ai < 2; ++ai)
#pragma unroll
        for (int m = 0; m < 4; ++m) {
          const int row = u.pm * 256 + ai * 128 + wr * 64 + m * 16 + fr, c0 = u.pn * 256 + bj * 128 + wc * 32 + 8 * fq;
          const float* gt = MODF + tok_mod_idx(row) * 3072 + 2048 + c0;
          float hv[8];
          if (l == 0) {
            const float* hp = (row < NPT ? x_prompt + (long)row * 1024 : x_sample + (long)(row - NPT) * 1024) + c0;
            const f32x4 h0 = *(const f32x4*)hp, h1 = *(const f32x4*)(hp + 4);
#pragma unroll
            for (int e = 0; e < 4; ++e) { hv[e] = h0[e]; hv[4 + e] = h1[e]; }
          } else {
            const u32x4 hw = *(const u32x4*)(hb_in + (long)row * 1024 + c0);
            hv[0] = bf_lo(hw.x); hv[1] = bf_hi(hw.x); hv[2] = bf_lo(hw.y); hv[3] = bf_hi(hw.y);
            hv[4] = bf_lo(hw.z); hv[5] = bf_hi(hw.z); hv[6] = bf_lo(hw.w); hv[7] = bf_hi(hw.w);
          }
          const f32x4 g0 = *(const f32x4*)gt, g1 = *(const f32x4*)(gt + 4);
          const pg8::f32x4 v0 = acc[ai][bj][m][0], v1 = acc[ai][bj][m][1];
          u32x4 w;
          w.x = pk_bf16(hv[0] + g0[0] * v0[0], hv[1] + g0[1] * v0[1]); w.y = pk_bf16(hv[2] + g0[2] * v0[2], hv[3] + g0[3] * v0[3]);
          w.z = pk_bf16(hv[4] + g1[0] * v1[0], hv[5] + g1[1] * v1[1]); w.w = pk_bf16(hv[6] + g1[2] * v1[2], hv[7] + g1[3] * v1[3]);
          *(u32x4*)(hb_out + (long)row * 1024 + c0) = w;
        }
  }
};
DI void phase_wout(const Params& p, int l, unsigned char* smem) {
  pg8::Gemm g{(const bf16_t*)(p.ws + OFF_Y), (const bf16_t*)(p.ws + OFF_WOUTT) + (long)l * 1024 * 1024, NTOK, 1024, 1024, 1024, 1024};
  pg8::StaticOrder S;
  S.init(NTOK, 1024, gridDim.x, blockIdx.x);
  EpiWout E{p.x_prompt, p.x_sample, (const bf16_t*)p.out, l == 0 ? (bf16_t*)p.out : (bf16_t*)(p.ws + OFF_XN), (const float*)(p.ws + OFF_MODF) + l * 9216, l};
  __syncthreads();
  pg8::gemm_phase<EpiWout, pg8::StaticOrder, true, true>((PG8_LAS unsigned char*)smem, g, S, E);
}

DI void phase_final(const Params& p) {
  const int tid = hide_tid();
  const int wave = tid >> 6, lane = tid & 63;
  for (int row = blockIdx.x * NWAVE + wave; row < NTOK; row += gridDim.x * NWAVE) {
    float* src = p.out + (long)row * 1024;
    const bf16_t* srcb = (const bf16_t*)(p.ws + OFF_XN) + (long)row * 1024;
    f32x4 x[4];
    float ss = 0.f;
#pragma unroll
    for (int j = 0; j < 4; ++j) {
      const u32x2 hw = *(const u32x2*)(srcb + j * 256 + lane * 4);
      x[j] = (f32x4){bf_lo(hw.x), bf_hi(hw.x), bf_lo(hw.y), bf_hi(hw.y)};
      ss += x[j][0] * x[j][0] + x[j][1] * x[j][1] + x[j][2] * x[j][2] + x[j][3] * x[j][3];
    }
    ss = wave_sum(ss);
    const float r = rsqrtf(ss * (1.f / 1024.f) + EPS);
#pragma unroll
    for (int j = 0; j < 4; ++j) {
      const f32x4 g = *(const f32x4*)(p.final_norm_g + j * 256 + lane * 4);
      f32x4 o = {x[j][0] * r * g[0], x[j][1] * r * g[1], x[j][2] * r * g[2], x[j][3] * r * g[3]};
      *(f32x4*)(src + j * 256 + lane * 4) = o;
    }
  }
}

#define XB_TMO      128
#define XB_XCNT(j)  (256  + 64 * (j))
#define XB_XSUB(j)  (1280 + 64 * (j))
#define XB_XGEN(j)  (2304 + 64 * (j))
#define XB_TOP      3328
#define XB_TOPGEN   3392
#define XB_SPIN_CAP (1u << 18)
#define LAS __attribute__((address_space(3)))
DI unsigned xb_ld(unsigned* p)              { return __hip_atomic_load(p, __ATOMIC_RELAXED, __HIP_MEMORY_SCOPE_AGENT); }
DI unsigned xb_add(unsigned* p, unsigned v) { return __hip_atomic_fetch_add(p, v, __ATOMIC_RELAXED, __HIP_MEMORY_SCOPE_AGENT); }
DI unsigned xb_xcc_id() { return (unsigned)__builtin_amdgcn_s_getreg((3 << 11) | 20) & 0xFu; }
#define XB_SPIN(cond, bar) do { unsigned _sp = 0; while (cond) { __builtin_amdgcn_s_sleep(1); \
    if ((++_sp & 255u) == 0u) { if (xb_ld(&(bar)[XB_TMO])) break; if (_sp > XB_SPIN_CAP) { atomicAdd(&(bar)[XB_TMO], 1u); break; } } } } while (0)
struct XcdBarrier { unsigned* bar; unsigned x; volatile LAS unsigned* st; };
DI XcdBarrier xcd_barrier_post(unsigned* bar, volatile LAS unsigned* st) {
  XcdBarrier b; b.bar = bar; b.x = xb_xcc_id(); b.st = st;
  if (threadIdx.x == 0) (void)xb_add(&bar[XB_XCNT(b.x)], 1u);
  return b;
}
DI void xcd_barrier_complete(unsigned* bar, unsigned x, unsigned& nloc, unsigned& nx) {
  const unsigned G = gridDim.x * gridDim.y * gridDim.z;
  unsigned sum, cnt, mine, sp = 0u;
  for (;;) {
    sum = 0u; cnt = 0u; mine = 0u;
#pragma unroll
    for (unsigned j = 0; j < 16; ++j) { const unsigned c = xb_ld(&bar[XB_XCNT(j)]); sum += c; cnt += (c > 0u) ? 1u : 0u; mine = (j == x) ? c : mine; }
    if (sum == G) break;
    __builtin_amdgcn_s_sleep(1);
    if ((++sp & 255u) == 0u) { if (xb_ld(&bar[XB_TMO])) break; if (sp > XB_SPIN_CAP) { atomicAdd(&bar[XB_TMO], 1u); break; } }
  }
  nloc = mine > 0u ? mine : 1u; nx = cnt > 0u ? cnt : 1u;
}
DI void xcd_barrier(unsigned* bar_in, volatile LAS unsigned* st_in) {
  XcdBarrier b; b.bar = bar_in; b.x = xb_xcc_id(); b.st = st_in;
  asm volatile("s_waitcnt vmcnt(0)" ::: "memory");
  __syncthreads();
  if (threadIdx.x == 0) {
    unsigned* bar = b.bar;
    __builtin_amdgcn_s_waitcnt(0);
    unsigned nloc = b.st[0], nx = b.st[1];
    if (nloc == 0u) { xcd_barrier_complete(bar, b.x, nloc, nx); b.st[0] = nloc; b.st[1] = nx; }
    const unsigned old = xb_add(&bar[XB_XSUB(b.x)], 1u);
    const unsigned gen = old / nloc;
    if (old + 1u == (gen + 1u) * nloc) {
      __builtin_amdgcn_fence(__ATOMIC_RELEASE, "agent");
      asm volatile("s_waitcnt vmcnt(0)" ::: "memory");
      const unsigned og = xb_add(&bar[XB_TOP], 1u);
      const unsigned tg = og / nx;
      if (og + 1u == (tg + 1u) * nx) xb_add(&bar[XB_TOPGEN], 1u);
      else XB_SPIN(xb_ld(&bar[XB_TOPGEN]) == tg, bar);
      __builtin_amdgcn_fence(__ATOMIC_ACQUIRE, "agent");
      xb_add(&bar[XB_XGEN(b.x)], 1u);
      asm volatile("s_waitcnt vmcnt(0)" ::: "memory");
    } else {
      XB_SPIN(xb_ld(&bar[XB_XGEN(b.x)]) == gen, bar);
      __builtin_amdgcn_fence(__ATOMIC_ACQUIRE, "agent");
      asm volatile("s_waitcnt vmcnt(0)" ::: "memory");
    }
  }
  __syncthreads();
}

#ifndef PROBE_MASK
#define PROBE_MASK 0
#endif
#define GSYNC() xcd_barrier((unsigned*)(p.ws + OFF_BAR), (volatile LAS unsigned*)&xb_words)
#define PROBE_REP(bit, stmt) do { stmt; if ((PROBE_MASK >> (bit)) & 1) { if (l == 0) { GSYNC(); stmt; } } } while (0)
__global__ void __launch_bounds__(NTHR, 2) fwd_mega(Params p) {
  cg::grid_group grid = cg::this_grid();
  extern __shared__ __attribute__((aligned(16))) unsigned char smem[];
  __shared__ uint4 xb_words;
  if (threadIdx.x == 0) xb_words = make_uint4(0u, 0u, 0u, 0u);
  __syncthreads();
  (void)xcd_barrier_post((unsigned*)(p.ws + OFF_BAR), (volatile LAS unsigned*)&xb_words);
  if (p.ph_lo) grid.sync();
  phase_prep_a(p, smem);
  GSYNC();
  phase_prep_b(p, smem);
  GSYNC();
  if ((PROBE_MASK >> 8) & 1) { for (int i = 0; i < 20; ++i) GSYNC(); }
  if ((PROBE_MASK >> 9) & 1) { phase_prep_a(p, smem); GSYNC(); phase_prep_b(p, smem); GSYNC(); }
#pragma unroll 1
  for (int l = 0; l < 2; ++l) {
    PROBE_REP(0, phase_xn(p, l));
    GSYNC();
    PROBE_REP(1, phase_win(p, l, smem));
    GSYNC();
    {
      const int G = gridDim.x, nwb = G > 64 ? 64 : G, bid = blockIdx.x;
      if (bid < nwb) phase_win_tail(p, l, smem, nwb);
      if (bid >= nwb || G == nwb) {
        const int first = G == nwb ? bid : bid - nwb, stride = G == nwb ? G : G - nwb;
        phase_lat(p, l, first, stride);
        phase_aux(p, l, smem, first, stride);
      }
    }
    GSYNC();
    PROBE_REP(3, phase_up(p, l, smem));
    GSYNC();
    PROBE_REP(4, phase_mix(p, l, smem));
    GSYNC();
    PROBE_REP(5, phase_merge(p, l, smem));
    GSYNC();
    PROBE_REP(6, phase_wout(p, l, smem));
    GSYNC();
  }
  phase_final(p);
}

extern "C" void kernel_launch(void* const* d_in, const int* in_sizes, int n_in, void* d_out, int out_size,
                              void* d_ws, size_t ws_size, hipStream_t stream) {
  constexpr size_t kDynLds = 131072;
  static int grid_blocks = 0;
  if (!grid_blocks) {
    int dev = 0, cus = 0, per_cu = 0;
    (void)hipGetDevice(&dev);
    (void)hipDeviceGetAttribute(&cus, hipDeviceAttributeMultiprocessorCount, dev);
    (void)hipFuncSetAttribute((const void*)fwd_mega, hipFuncAttributeMaxDynamicSharedMemorySize, (int)kDynLds);
    (void)hipOccupancyMaxActiveBlocksPerMultiprocessor(&per_cu, fwd_mega, NTHR, kDynLds);
    if (per_cu > 1) per_cu = 1;
    if (per_cu < 1) per_cu = 1;
    grid_blocks = cus * per_cu;
  }
  if (ws_size < WS_TOTAL) { fprintf(stderr, "workspace too small: %zu < %zu\n", ws_size, (size_t)WS_TOTAL); return; }
  Params p{};
  const float** f = (const float**)&p;
  for (int i = 0; i < 21; ++i) f[i] = (const float*)d_in[i];
  p.out = (float*)d_out;
  p.ws = (unsigned char*)d_ws;
  (void)hipMemsetAsync((unsigned char*)d_ws + OFF_BAR, 0, BAR_BYTES, stream);
  void* args[] = {&p};
  hipError_t e = hipLaunchCooperativeKernel((void*)fwd_mega, dim3(grid_blocks), dim3(NTHR), args, kDynLds, stream);
  if (e != hipSuccess) fprintf(stderr, "cooperative launch failed: %s (grid %d)\n", hipGetErrorString(e), grid_blocks);
}
```

```cpp
#include <hip/hip_runtime.h>
#include <hip/hip_cooperative_groups.h>
#include <cstdio>
#include <cstdint>
namespace cg = cooperative_groups;

#define DI __device__ __forceinline__
typedef unsigned short bf16_t;
typedef short bf16x8 __attribute__((ext_vector_type(8)));
typedef float f32x16 __attribute__((ext_vector_type(16)));
typedef float f32x4 __attribute__((ext_vector_type(4)));
typedef float f32x2 __attribute__((ext_vector_type(2)));
typedef unsigned u32x4 __attribute__((ext_vector_type(4)));
typedef unsigned u32x2 __attribute__((ext_vector_type(2)));
typedef __bf16 bf16x2_t __attribute__((ext_vector_type(2)));

constexpr int NTHR = 512, NWAVE = 8;
constexpr int D = 1024, NTOK = 16384, NPT = 8192, LP = 256, LS = 4096, LKS = 4608, PAST = 512;
constexpr int NEXT = 2208, NEXTP = 2304, PW = 1280, LATW = 416;
constexpr int LDX = 1024;
constexpr int PC_AZ = 0, PC_BIN = 256, PC_BZ = 512, PC_CZ = 768;
constexpr int NROWS_KV = NTOK + 2 * PAST;
constexpr float EPS = 1e-6f;
constexpr float QSCALE = 0.10206207261596577f * 1.4426950408889634f;

constexpr size_t al256(size_t x) { return (x + 255) & ~(size_t)255; }
constexpr size_t OFF_WINT = 0;
constexpr size_t OFF_WGT = OFF_WINT + al256((size_t)2 * NEXTP * LDX * 2);
constexpr size_t OFF_WQT = OFF_WGT + al256((size_t)2 * 3072 * LDX * 2);
constexpr size_t OFF_WKVT = OFF_WQT + al256((size_t)2 * 768 * 256 * 2);
constexpr size_t OFF_WBRT = OFF_WKVT + al256((size_t)2 * 1024 * 128 * 2);
constexpr size_t OFF_WOUTT = OFF_WBRT + al256((size_t)2 * 1024 * 1024 * 2);
constexpr size_t OFF_POOLWT = OFF_WOUTT + al256((size_t)2 * 1024 * 1024 * 2);
constexpr size_t OFF_MODP = OFF_POOLWT + al256((size_t)2 * 256 * 256 * 2);
constexpr size_t OFF_MODF = OFF_MODP + al256((size_t)16 * 2 * 3 * 3072 * 4);
constexpr size_t OFF_ROPE = OFF_MODF + al256((size_t)2 * 3 * 3072 * 4);
constexpr size_t OFF_DP = OFF_ROPE + al256((size_t)2 * 4096 * 32 * 4);
constexpr size_t OFF_A1 = OFF_DP + al256((size_t)256 * 512 * 2);
constexpr size_t OFF_D2 = OFF_A1 + al256((size_t)256 * 256 * 2);
constexpr size_t OFF_XN = OFF_D2 + al256((size_t)16 * 256 * 512 * 2);
constexpr size_t OFF_P = OFF_XN + al256((size_t)NTOK * LDX * 2);
constexpr size_t OFF_X = OFF_P + al256((size_t)NTOK * PW * 2);
constexpr size_t OFF_LAT = OFF_X;
constexpr size_t OFF_ATP = OFF_X + al256((size_t)NTOK * 1024 * 2);
constexpr size_t OFF_G = OFF_ATP;
constexpr size_t OFF_Z = OFF_ATP + al256((size_t)32 * 256 * 512 * 2);
constexpr size_t OFF_Y1 = OFF_Z + al256((size_t)2 * 256 * 64 * 128 * 2);
constexpr size_t OFF_QN = OFF_Y1 + al256((size_t)2 * 256 * 64 * 128 * 2);
constexpr size_t OFF_CKVB = OFF_QN + al256((size_t)NTOK * 256 * 2);
constexpr size_t OFF_Q = OFF_CKVB + al256((size_t)NROWS_KV * 128 * 2);
constexpr size_t OFF_Y = OFF_Q;
constexpr size_t OFF_KP = OFF_Q + al256((size_t)NTOK * 8 * 96 * 2);
constexpr size_t OFF_KS = OFF_KP + al256((size_t)32 * 8 * 256 * 64 * 2);
constexpr size_t OFF_KR = OFF_KS + al256((size_t)2 * 8 * LKS * 64 * 2);
constexpr size_t OFF_VTP = OFF_KR + al256((size_t)(NPT + 2 * LKS) * 32 * 2);
constexpr size_t OFF_VTS = OFF_VTP + al256((size_t)32 * 8 * 64 * 256 * 2);
constexpr size_t OFF_PB = OFF_VTS + al256((size_t)2 * 8 * 64 * LKS * 2);
constexpr size_t OFF_CTR = OFF_PB + al256((size_t)NTOK * 256 * 2);
constexpr size_t OFF_BAR = OFF_CTR + 256;
constexpr size_t BAR_BYTES = 3456 * 4;
constexpr size_t WS_TOTAL = OFF_BAR + al256(BAR_BYTES);
static_assert(OFF_KS - OFF_Q >= (size_t)NTOK * 1024 * 2, "Y overlay");
static_assert(OFF_CKVB - OFF_ATP >= (size_t)NTOK * 1024 * 2, "G overlay");
static_assert(OFF_CTR - OFF_KS >= (size_t)NTOK * 1024 * 2 && OFF_X - OFF_P >= (size_t)NTOK * 1024 * 2, "G1/G2 overlays");
static_assert((size_t)NTOK * LATW * 4 <= (size_t)NTOK * 1024 * 2, "LAT overlay");
static_assert(WS_TOTAL <= (size_t)256 * 1024 * 1024, "workspace");

constexpr long OUT_CKV = (long)NTOK * 1024;
constexpr long OUT_KR = OUT_CKV + (long)32 * 2 * 256 * 128;

struct Params {
  const float *x_prompt, *x_sample, *cache_ckv, *cache_krope, *c, *c_ctx, *norm_g, *w_mod, *b_mod, *w_in, *pool_w, *pool_scale,
      *q_norm_g, *w_q_up, *kv_norm_g, *w_kv_up, *w_br_a, *w_br_b, *w_br_c, *w_out, *final_norm_g;
  float* out;
  unsigned char* ws;
  int ph_lo, ph_hi;
};

DI unsigned pk_bf16(float lo, float hi) { f32x2 v = {lo, hi}; bf16x2_t r = __builtin_convertvector(v, bf16x2_t); return __builtin_bit_cast(unsigned, r); }
DI bf16_t f2bf(float x) { return (bf16_t)(pk_bf16(x, 0.f) & 0xffffu); }
DI float bf_lo(unsigned u) { return __uint_as_float(u << 16); }
DI float bf2f_(bf16_t u) { return __uint_as_float(((unsigned)u) << 16); }
DI float bf_hi(unsigned u) { return __uint_as_float(u & 0xffff0000u); }
DI float sigmoid_f(float x) { return __builtin_amdgcn_rcpf(1.f + __expf(-x)); }
DI float silu_f(float x) { return x * sigmoid_f(x); }
DI float wave_sum(float v) {
#pragma unroll
  for (int o = 32; o > 0; o >>= 1) v += __shfl_xor(v, o);
  return v;
}
DI int hide_tid() { int t = threadIdx.x; asm volatile("" : "+v"(t)); return t; }
DI int virt_block() { const int g8 = gridDim.x >> 3; return (blockIdx.x & 7) * g8 + (blockIdx.x >> 3); }
DI void tile_decode(int u, int NT, int& mt, int& nt) { const int gm = u / (8 * NT), r = u - gm * 8 * NT; nt = r >> 3; mt = gm * 8 + (r & 7); }
DI int tok_mod_idx(int t) { return t < NPT ? 0 : 1 + ((t - NPT) >> 12); }

#define LDSP __attribute__((address_space(3)))
constexpr int GM_STAGE = 65536, GM_BOFF = 32768;
DI void gemm_dma(int tid, const bf16_t* __restrict__ A, long lda, const bf16_t* __restrict__ Bt, long ldb, int k0, unsigned char* st) {
  const int wave = tid >> 6, lane = tid & 63, rl = lane >> 3, slot = lane & 7;
#pragma unroll
  for (int q = 0; q < 4; ++q) {
    const int r = 64 * q + 8 * wave + rl;
    const int ch = slot ^ ((r >> 1) & 7);
    unsigned char* dst = st + (8 * q + wave) * 1024;
    __builtin_amdgcn_global_load_lds((const unsigned*)(A + (long)r * lda + k0 + ch * 8), (LDSP unsigned*)dst, 16, 0, 0);
    __builtin_amdgcn_global_load_lds((const unsigned*)(Bt + (long)r * ldb + k0 + ch * 8), (LDSP unsigned*)(dst + GM_BOFF), 16, 0, 0);
  }
}
DI void gemm_dma_b(int tid, const bf16_t* __restrict__ Bt, long ldb, int k0, unsigned char* st) {
  const int wave = tid >> 6, lane = tid & 63, rl = lane >> 3, slot = lane & 7;
#pragma unroll
  for (int q = 0; q < 4; ++q) {
    const int r = 64 * q + 8 * wave + rl;
    const int ch = slot ^ ((r >> 1) & 7);
    __builtin_amdgcn_global_load_lds((const unsigned*)(Bt + (long)r * ldb + k0 + ch * 8), (LDSP unsigned*)(st + (8 * q + wave) * 1024 + GM_BOFF), 16, 0, 0);
  }
}
DI void gemm_compute(int tid, const unsigned char* st, f32x16 (&acc)[4][2]) {
  const int wave = tid >> 6, lane = tid & 63, wm = wave >> 2, wn = wave & 3, r = lane & 31, hh = lane >> 5;
#pragma unroll
  for (int s = 0; s < 4; ++s) {
    const int sw = ((2 * s + hh) ^ ((r >> 1) & 7)) << 4;
    bf16x8 af[4], bf[2];
#pragma unroll
    for (int i = 0; i < 4; ++i) af[i] = *(const bf16x8*)(st + (wm * 128 + i * 32 + r) * 128 + sw);
#pragma unroll
    for (int i = 0; i < 2; ++i) bf[i] = *(const bf16x8*)(st + GM_BOFF + (wn * 64 + i * 32 + r) * 128 + sw);
#pragma unroll
    for (int mi = 0; mi < 4; ++mi)
#pragma unroll
      for (int ni = 0; ni < 2; ++ni) acc[mi][ni] = __builtin_amdgcn_mfma_f32_32x32x16_bf16(bf[ni], af[mi], acc[mi][ni], 0, 0, 0);
  }
}
DI void gemm_main(int tid, const bf16_t* __restrict__ A, long lda, const bf16_t* __restrict__ Bt, long ldb, int K, f32x16 (&acc)[4][2], unsigned char* smem, int kper = 0) {
  const int nk = K >> 6;
  gemm_dma(tid, A, lda, Bt, ldb, 0, smem);
  asm volatile("s_waitcnt vmcnt(0)" ::: "memory");
  __syncthreads();
  for (int kt = 0; kt < nk; ++kt) {
    if (kt + 1 < nk) gemm_dma(tid, A, lda, Bt, ldb, (kt + 1) * 64, smem + ((kt + 1) & 1) * GM_STAGE);
    if (kper == 0 || __builtin_amdgcn_readfirstlane(kt / kper == ((tid >> 6) & 3))) gemm_compute(tid, smem + (kt & 1) * GM_STAGE, acc);
    asm volatile("s_waitcnt vmcnt(0)" ::: "memory");
    __syncthreads();
  }
}
DI void acc_zero(f32x16 (&acc)[4][2]) {
#pragma unroll
  for (int a = 0; a < 4; ++a)
#pragma unroll
    for (int b = 0; b < 2; ++b)
#pragma unroll
      for (int i = 0; i < 16; ++i) acc[a][b][i] = 0.f;
}
template <class F> DI void epi_blocks(int tid, const f32x16 (&acc)[4][2], int m0, int n0, F f) {
  const int wave = tid >> 6, lane = tid & 63, wm = wave >> 2, wn = wave & 3, r = lane & 31, hh = lane >> 5;
#pragma unroll
  for (int mi = 0; mi < 4; ++mi)
#pragma unroll
    for (int ni = 0; ni < 2; ++ni) f(m0 + wm * 128 + mi * 32 + r, n0 + wn * 64 + ni * 32, hh, acc[mi][ni]);
}

namespace pg8 {
#define PG8_LAS __attribute__((address_space(3)))
typedef float f32x4 __attribute__((ext_vector_type(4)));
constexpr int BM = 256, BK = 64, HALF = 128, HTB = HALF * BK * 2, STAGE_BYTES = 8 * HTB, NXCD = 8, WGM = 8;
__host__ __device__ __forceinline__ int lds_byte(int r, int c) { const int st = (r >> 4) * 2 + (c >> 5), rr = r & 15, cc = c & 31, ob = rr * 64 + cc * 2; return st * 1024 + (ob ^ (((ob >> 9) & 1) << 5)); }
__host__ __device__ __forceinline__ void stage_rc(int b, int& R, int& C) { const int st = b / 1024, sb = b % 1024, swz = sb ^ (((sb >> 9) & 1) << 5); R = (st >> 1) * 16 + swz / 64; C = (st & 1) * 32 + (swz % 64) / 2; }
__host__ __device__ __forceinline__ int perm32(int rho) { const int n = rho >> 4, i = rho & 15; return 8 * (i >> 2) + 4 * n + (i & 3); }
struct Unit { int pm, pn; int koff = 0, K = 0; };
struct Gemm { const bf16_t* A; const bf16_t* Bt; int M, N, K; int lda, ldb; };
struct StaticOrder {
    int nM, nN, nwg, G, c;
    __host__ __device__ void init(int M, int N, int G_, int c_) { nM = M / BM; nN = N / BM; nwg = nM * nN; G = G_; c = c_; }
    __host__ __device__ bool next(int i, Unit& u) const {
        const long L = (long)i * G + c; if (L >= nwg) return false;
        int wgid = (int)L; { const int q = nwg / NXCD, r = nwg % NXCD, xcd = wgid % NXCD, off = wgid / NXCD; wgid = (xcd < r ? xcd * (q + 1) : r * (q + 1) + (xcd - r) * q) + off; }
        const int nig = WGM * nN, gid = wgid / nig, fm = gid * WGM, gsz = (nM - fm) < WGM ? (nM - fm) : WGM;
        u.pm = fm + ((wgid % nig) % gsz); u.pn = (wgid % nig) / gsz; return true;
    }
    __device__ __forceinline__ void a_ready(const Unit&) const {}
    __device__ __forceinline__ void done(const Unit&) const {}
};
template <class Epi, class Sched, bool ALIGN_EPI = false, bool SP2 = false>
__device__ __forceinline__ void gemm_phase(PG8_LAS unsigned char* lds, const Gemm g, const Sched& S, const Epi& E) {
    int tid = threadIdx.x;
    asm volatile("" : "+v"(tid));
    const int wid = __builtin_amdgcn_readfirstlane(tid >> 6), lane = tid & 63, wr = wid >> 2, wc = wid & 3, fr = lane & 15, fq = lane >> 4;
    int K = g.K;
    asm volatile("" : "+s"(K));
    int nt = K / BK;
    unsigned voffA[2], voffB[2];
#pragma unroll
    for (int i = 0; i < 2; ++i) { int R, C; stage_rc(tid * 16 + i * 8192, R, C); const int Rb = Epi::PERM ? ((R & ~31) + perm32(R & 31)) : R;
        voffA[i] = (unsigned)(R * g.lda + C) * 2u; voffB[i] = (unsigned)(Rb * g.ldb + C) * 2u; }
    const size_t kstep = (size_t)(BK * 2);
    const size_t hstepA = (size_t)HALF * g.lda * 2, hstepB = (size_t)HALF * g.ldb * 2;
    const size_t tstepA = 2 * hstepA, tstepB = 2 * hstepB;
    const unsigned ldsw = (unsigned)wid * 1024u;
    const int aoff = lds_byte(wr * 64 + fr, fq * 8), boff = lds_byte(wc * 32 + fr, fq * 8);
#define PG8_SA(b, h) (((b) * 2 + (h)) * HTB)
#define PG8_SB(b, h) ((4 + (b) * 2 + (h)) * HTB)
#define PG8_STAGE(bufoff, gbase, voff) do { _Pragma("unroll") for (int _i = 0; _i < 2; ++_i) \
        __builtin_amdgcn_global_load_lds((const unsigned*)((const char*)(gbase) + (voff)[_i]), (PG8_LAS unsigned*)(lds + (bufoff) + ldsw + _i * 8192), 16, 0, 0); } while (0)
#define PG8_LDA(dst, b, h) do { _Pragma("unroll") for (int m = 0; m < 4; ++m) _Pragma("unroll") for (int k = 0; k < 2; ++k) dst[m][k] = *(const PG8_LAS bf16x8*)(lds + PG8_SA(b, h) + aoff + m * 2048 + k * 1024); } while (0)
#define PG8_LDB(dst, b, h) do { _Pragma("unroll") for (int n = 0; n < 2; ++n) _Pragma("unroll") for (int k = 0; k < 2; ++k) dst[n][k] = *(const PG8_LAS bf16x8*)(lds + PG8_SB(b, h) + boff + n * 2048 + k * 1024); } while (0)
#define PG8_MMA(ai, bj, At, Bt) do { __builtin_amdgcn_s_setprio(1); _Pragma("unroll") for (int m = 0; m < 4; ++m) _Pragma("unroll") for (int n = 0; n < 2; ++n) _Pragma("unroll") for (int k = 0; k < 2; ++k) \
        acc[ai][bj][m][n] = __builtin_amdgcn_mfma_f32_16x16x32_bf16(Bt[n][k], At[m][k], acc[ai][bj][m][n], 0, 0, 0); __builtin_amdgcn_s_setprio(0); } while (0)
#define PG8_WAIT_V(n) asm volatile("s_waitcnt vmcnt(" #n ")" ::: "memory")
#define PG8_WAIT_L(n) asm volatile("s_waitcnt lgkmcnt(" #n ")" ::: "memory")
#define PG8_BAR __builtin_amdgcn_s_barrier()
#define PG8_SCHED __builtin_amdgcn_sched_barrier(0)
    Unit cur, nxt; int ui = 0;
    if (!S.next(0, cur)) return;
    f32x4 acc[2][2][4][2];
#pragma unroll
    for (int a = 0; a < 2; ++a)
#pragma unroll
        for (int b = 0; b < 2; ++b)
#pragma unroll
            for (int m = 0; m < 4; ++m)
#pragma unroll
                for (int n = 0; n < 2; ++n) acc[a][b][m][n] = (f32x4){0.f, 0.f, 0.f, 0.f};
    bf16x8 At[4][2], B0[2][2], B1[2][2];
    if (cur.K) nt = cur.K / BK;
    const char* cA = (const char*)g.A + (size_t)cur.pm * tstepA + (size_t)cur.koff * 2; const char* cB = (const char*)g.Bt + (size_t)cur.pn * tstepB + (size_t)cur.koff * 2;
    S.a_ready(cur);
    if constexpr (SP2) {
        PG8_STAGE(PG8_SB(0, 0), cB, voffB); PG8_STAGE(PG8_SB(0, 1), cB + hstepB, voffB); PG8_STAGE(PG8_SA(0, 0), cA, voffA); PG8_STAGE(PG8_SA(0, 1), cA + hstepA, voffA);
        if (wr == 1) PG8_BAR;
        PG8_WAIT_V(2); PG8_BAR;
        PG8_STAGE(PG8_SB(1, 0), cB + kstep, voffB); PG8_STAGE(PG8_SA(1, 0), cA + kstep, voffA); PG8_STAGE(PG8_SB(1, 1), cB + hstepB + kstep, voffB);
        PG8_WAIT_V(6); PG8_BAR;
    } else {
        PG8_STAGE(PG8_SB(0, 0), cB, voffB); PG8_STAGE(PG8_SA(0, 0), cA, voffA); PG8_STAGE(PG8_SB(0, 1), cB + hstepB, voffB); PG8_STAGE(PG8_SA(0, 1), cA + hstepA, voffA);
        if (wr == 1) PG8_BAR;
        PG8_WAIT_V(4); PG8_BAR;
        PG8_STAGE(PG8_SB(1, 0), cB + kstep, voffB); PG8_STAGE(PG8_SA(1, 0), cA + kstep, voffA); PG8_STAGE(PG8_SB(1, 1), cB + hstepB + kstep, voffB);
        PG8_WAIT_V(6); PG8_BAR;
    }
    for (;;) {
        const bool has_next = S.next(ui + 1, nxt);
        const char* nA = has_next ? (const char*)g.A + (size_t)nxt.pm * tstepA + (size_t)nxt.koff * 2 : cA; const char* nB = has_next ? (const char*)g.Bt + (size_t)nxt.pn * tstepB + (size_t)nxt.koff * 2 : cB;
        for (int t = 0; t < nt; t += 2) {
            const bool last = (t == nt - 2);
            const char* a1 = cA + (size_t)(t + 1) * kstep;
            const char* a2 = last ? nA : cA + (size_t)(t + 2) * kstep; const char* b2 = last ? nB : cB + (size_t)(t + 2) * kstep;
            const char* a3 = a2 + kstep; const char* b3 = b2 + kstep;
            if (last && has_next) S.a_ready(nxt);
            if constexpr (SP2) {
            PG8_LDB(B0, 0, 0); PG8_LDB(B1, 0, 1); PG8_SCHED; PG8_LDA(At, 0, 0); PG8_STAGE(PG8_SA(1, 1), a1 + hstepA, voffA);
            PG8_WAIT_V(8); PG8_WAIT_L(0); PG8_BAR; PG8_MMA(0, 0, At, B0); PG8_MMA(0, 1, At, B1); PG8_BAR; PG8_SCHED;
            PG8_LDA(At, 0, 1); PG8_STAGE(PG8_SB(0, 0), b2, voffB); PG8_STAGE(PG8_SB(0, 1), b2 + hstepB, voffB); PG8_STAGE(PG8_SA(0, 0), a2, voffA);
            PG8_WAIT_V(8); PG8_WAIT_L(0); PG8_BAR; PG8_MMA(1, 0, At, B0); PG8_MMA(1, 1, At, B1); PG8_BAR; PG8_SCHED;
            PG8_LDB(B0, 1, 0); PG8_LDB(B1, 1, 1); PG8_SCHED; PG8_LDA(At, 1, 0); PG8_STAGE(PG8_SA(0, 1), a2 + hstepA, voffA);
            PG8_WAIT_V(8); PG8_WAIT_L(0); PG8_BAR; PG8_MMA(0, 0, At, B0); PG8_MMA(0, 1, At, B1); PG8_BAR; PG8_SCHED;
            PG8_LDA(At, 1, 1); PG8_STAGE(PG8_SB(1, 0), b3, voffB); PG8_STAGE(PG8_SB(1, 1), b3 + hstepB, voffB); PG8_STAGE(PG8_SA(1, 0), a3, voffA);
            PG8_WAIT_V(8); PG8_WAIT_L(0); PG8_BAR; PG8_MMA(1, 0, At, B0); PG8_MMA(1, 1, At, B1); PG8_BAR; PG8_SCHED;
            } else {
            PG8_LDB(B0, 0, 0); PG8_SCHED; PG8_LDA(At, 0, 0); PG8_STAGE(PG8_SA(1, 1), a1 + hstepA, voffA);
            PG8_WAIT_L(8); PG8_BAR; PG8_WAIT_L(0); PG8_MMA(0, 0, At, B0); PG8_BAR; PG8_SCHED;
            PG8_LDB(B1, 0, 1); PG8_STAGE(PG8_SB(0, 0), b2, voffB);
            PG8_BAR; PG8_WAIT_L(0); PG8_MMA(0, 1, At, B1); PG8_BAR;
            PG8_LDA(At, 0, 1); PG8_STAGE(PG8_SA(0, 0), a2, voffA);
            PG8_BAR; PG8_WAIT_L(0); PG8_MMA(1, 0, At, B0); PG8_BAR; PG8_SCHED;
            PG8_STAGE(PG8_SB(0, 1), b2 + hstepB, voffB);
            PG8_WAIT_V(6); PG8_BAR; PG8_MMA(1, 1, At, B1); PG8_BAR;
            PG8_LDB(B0, 1, 0); PG8_SCHED; PG8_LDA(At, 1, 0); PG8_STAGE(PG8_SA(0, 1), a2 + hstepA, voffA);
            PG8_WAIT_L(8); PG8_BAR; PG8_WAIT_L(0); PG8_MMA(0, 0, At, B0); PG8_BAR; PG8_SCHED;
            PG8_LDB(B1, 1, 1); PG8_STAGE(PG8_SB(1, 0), b3, voffB);
            PG8_BAR; PG8_WAIT_L(0); PG8_MMA(0, 1, At, B1); PG8_BAR;
            PG8_LDA(At, 1, 1); PG8_STAGE(PG8_SA(1, 0), a3, voffA);
            PG8_BAR; PG8_WAIT_L(0); PG8_MMA(1, 0, At, B0); PG8_BAR; PG8_SCHED;
            PG8_STAGE(PG8_SB(1, 1), b3 + hstepB, voffB);
            PG8_WAIT_V(6); PG8_BAR; PG8_MMA(1, 1, At, B1); PG8_BAR;
            }
        }
        if constexpr (ALIGN_EPI) { if (wr == 0) PG8_BAR; }
        if constexpr (!Epi::AFTER_DRAIN) { E(acc, cur, wr, wc, fr, fq); S.done(cur); }
        if (!has_next) break;
#pragma unroll
        for (int a = 0; a < 2; ++a)
#pragma unroll
            for (int b = 0; b < 2; ++b)
#pragma unroll
                for (int m = 0; m < 4; ++m)
#pragma unroll
                    for (int n = 0; n < 2; ++n) acc[a][b][m][n] = (f32x4){0.f, 0.f, 0.f, 0.f};
        cur = nxt; cA = nA; cB = nB; ++ui; if (cur.K) nt = cur.K / BK;
        if constexpr (ALIGN_EPI) { if (wr == 1) PG8_BAR; }
    }
    PG8_WAIT_V(0);
    if constexpr (!ALIGN_EPI) { if (wr == 0) PG8_BAR; }
    PG8_BAR;
    if constexpr (Epi::AFTER_DRAIN) { E.fused(acc, cur, wr, wc, fr, fq, lds, wid, lane); S.done(cur); }
#undef PG8_SA
#undef PG8_SB
#undef PG8_STAGE
#undef PG8_LDA
#undef PG8_LDB
#undef PG8_MMA
#undef PG8_WAIT_V
#undef PG8_WAIT_L
#undef PG8_BAR
#undef PG8_SCHED
}
}

DI void transpose_unit(const float* __restrict__ src, int ldsrc, int n_src0, int n_cnt, int kt, int nt, bf16_t* __restrict__ dst, long dst_ld,
                       int dst_n0, int dst_k0, int mode, unsigned char* smem, int tid512) {
  const int half = tid512 >> 8, tid = tid512 & 255;
  float* T = (float*)(smem + half * 20480);
  float* tab = (float*)(smem + 40960);
  const int k0 = kt * 64, nn0 = nt * 64;
  __syncthreads();
  if (tid512 < 64) tab[tid512] = __builtin_amdgcn_cosf((float)tid512 * (1.f / 64.f)) * 0.125f;
  {
    const int col = tid & 63, rq = tid >> 6;
#pragma unroll
    for (int i = 0; i < 16; ++i) {
      const int k = rq + 4 * i, n = nn0 + col;
      T[k * 65 + col] = (n < n_cnt) ? src[(long)(k0 + k) * ldsrc + n_src0 + n] : 0.f;
    }
  }
  __syncthreads();
  const int n = tid >> 2, q = tid & 3;
  float v[16];
  if (mode == 0) {
#pragma unroll
    for (int j = 0; j < 16; ++j) v[j] = T[(q * 16 + j) * 65 + n];
  } else {
#pragma unroll
    for (int j = 0; j < 16; ++j) v[j] = 0.f;
    const int sh = mode == 2 ? 48 : 0;
    for (int c = 0; c < 64; ++c) {
      const float w = tab[(c * n + sh) & 63];
#pragma unroll
      for (int j = 0; j < 16; ++j) v[j] += T[(q * 16 + j) * 65 + c] * w;
    }
  }
  if (nn0 + n < n_cnt) {
    u32x4 o0, o1;
    o0.x = pk_bf16(v[0], v[1]); o0.y = pk_bf16(v[2], v[3]); o0.z = pk_bf16(v[4], v[5]); o0.w = pk_bf16(v[6], v[7]);
    o1.x = pk_bf16(v[8], v[9]); o1.y = pk_bf16(v[10], v[11]); o1.z = pk_bf16(v[12], v[13]); o1.w = pk_bf16(v[14], v[15]);
    bf16_t* d = dst + (long)(dst_n0 + nn0 + n) * dst_ld + dst_k0 + k0 + q * 16;
    *(u32x4*)d = o0;
    *(u32x4*)(d + 8) = o1;
  }
}

DI void phase_prep_a(const Params& p, unsigned char* smem) {
  bf16_t* WinT = (bf16_t*)(p.ws + OFF_WINT);
  bf16_t* WgT = (bf16_t*)(p.ws + OFF_WGT);
  float* MODP = (float*)(p.ws + OFF_MODP);
  const int tid = hide_tid();
  const int half = tid >> 8;
  if (blockIdx.x == 0 && tid < 64) ((unsigned*)(p.ws + OFF_CTR))[tid] = 0u;
  const int N_MOD = 192, N_WIN = 2 * 16 * 14, N_WG = 2 * 16 * 24, N_FOLD = 2 * 16 * 4, N_ZERO = 2 * 96 * 128 / NTHR;
  const int total = N_MOD + N_WIN + N_WG + N_FOLD + N_ZERO;
  for (int u0 = blockIdx.x; u0 < total; u0 += gridDim.x) {
    int u = u0;
    if (u < N_MOD) {
      const int l = u / 96, rem = u % 96, cc = rem / 16, kc = rem % 16;
      float* s = (float*)smem;
      __syncthreads();
      if (tid < 192) {
        const int v = tid >> 6, k = tid & 63;
        const float cv = v == 0 ? p.c_ctx[kc * 64 + k] : p.c[(v - 1) * 1024 + kc * 64 + k];
        s[tid] = silu_f(cv);
      }
      __syncthreads();
      const int col = cc * 512 + tid;
      const float* w = p.w_mod + ((long)l * 1024 + kc * 64) * 3072 + col;
      float a0 = 0.f, a1 = 0.f, a2 = 0.f;
#pragma unroll 16
      for (int k = 0; k < 64; ++k) {
        const float wv = w[(long)k * 3072];
        a0 += s[k] * wv; a1 += s[64 + k] * wv; a2 += s[128 + k] * wv;
      }
      float* o = MODP + ((long)(kc * 2 + l) * 3) * 3072 + col;
      o[0] = a0; o[3072] = a1; o[6144] = a2;
      continue;
    }
    u -= N_MOD;
    if (u < N_WIN) {
      const int l = u / 224, rem = u % 224, kt = rem / 14, nt = 2 * (rem % 14) + half;
      transpose_unit(p.w_in + (long)l * 1024 * 5024, 5024, 256, 1696, kt, nt, WinT + (long)l * NEXTP * LDX, LDX, 512, 0, 0, smem, tid);
      continue;
    }
    u -= N_WIN;
    if (u < N_WG) {
      const int l = u / 384, rem = u % 384, kt = rem / 24, nt = 2 * (rem % 24) + half;
      transpose_unit(p.w_in + (long)l * 1024 * 5024, 5024, 1952, 3072, kt, nt, WgT + (long)l * 3072 * LDX, LDX, 0, 0, 0, smem, tid);
      continue;
    }
    u -= N_WG;
    if (u < N_FOLD) {
      const int l = u / 64, rem = u % 64, kt = rem / 4, g = rem & 3, part = half;
      transpose_unit(p.w_in + (long)l * 1024 * 5024, 5024, g * 64, 64, kt, 0, WinT + (long)l * NEXTP * LDX, LDX, part * 256 + g * 64, 0, 1 + part, smem, tid);
      continue;
    }
    u -= N_FOLD;
    {
      const long id = (long)u * NTHR + tid;
      const int l = (int)(id / (96 * 128)), rem = (int)(id % (96 * 128));
      u32x4 z = {0u, 0u, 0u, 0u};
      *(u32x4*)(WinT + (long)l * NEXTP * LDX + (long)(NEXT + rem / 128) * LDX + (long)(rem % 128) * 8) = z;
    }
  }
}

DI void phase_prep_b(const Params& p, unsigned char* smem) {
  const int tid = hide_tid();
  const int half = tid >> 8;
  float* tab = (float*)(smem + 65536);
  for (int i = tid; i < 4096; i += NTHR) tab[i] = __builtin_amdgcn_cosf((float)i * (1.f / 4096.f));
  __syncthreads();
  bf16_t* WqT = (bf16_t*)(p.ws + OFF_WQT);
  bf16_t* WkvT = (bf16_t*)(p.ws + OFF_WKVT);
  bf16_t* WbrT = (bf16_t*)(p.ws + OFF_WBRT);
  bf16_t* WoutT = (bf16_t*)(p.ws + OFF_WOUTT);
  bf16_t* PoolWt = (bf16_t*)(p.ws + OFF_POOLWT);
  const float* MODP = (const float*)(p.ws + OFF_MODP);
  float* MODF = (float*)(p.ws + OFF_MODF);
  float* ROPE = (float*)(p.ws + OFF_ROPE);
  bf16_t* Dp = (bf16_t*)(p.ws + OFF_DP);
  bf16_t* A1 = (bf16_t*)(p.ws + OFF_A1);
  bf16_t* D2 = (bf16_t*)(p.ws + OFF_D2);
  const int N_MODF = 36, N_WQ = 48, N_WKV = 32, N_BRA = 64, N_BRB = 64, N_BRC = 128, N_WOUT = 256, N_POOL = 256, N_ROPE = 256, N_DP = 32, N_A1 = 16, N_D2 = 512;
  const int total = N_MODF + N_WQ + N_WKV + N_BRA + N_BRB + N_BRC + N_WOUT + N_POOL + N_ROPE + N_DP + N_A1 + N_D2;
  for (int u0 = blockIdx.x; u0 < total; u0 += gridDim.x) {
    int u = u0;
    if (u < N_MODF) {
      const int idx = u * NTHR + tid;
      const int l = idx / 9216, rem = idx % 9216, col = rem % 3072;
      float a = p.b_mod[l * 3072 + col];
      for (int kc = 0; kc < 16; ++kc) a += MODP[(long)kc * 18432 + l * 9216 + rem];
      MODF[idx] = a;
      continue;
    }
    u -= N_MODF;
    if (u < N_WQ) { const int l = u / 24, rem = u % 24; transpose_unit(p.w_q_up + (long)l * 256 * 768, 768, 0, 768, rem / 6, 2 * (rem % 6) + half, WqT + (long)l * 768 * 256, 256, 0, 0, 0, smem, tid); continue; }
    u -= N_WQ;
    if (u < N_WKV) { const int l = u / 16, rem = u % 16; transpose_unit(p.w_kv_up + (long)l * 128 * 1024, 1024, 0, 1024, rem / 8, 2 * (rem % 8) + half, WkvT + (long)l * 1024 * 128, 128, 0, 0, 0, smem, tid); continue; }
    u -= N_WKV;
    if (u < N_BRA) { const int l = u / 32, rem = u % 32; transpose_unit(p.w_br_a + (long)l * 256 * 1024, 1024, 0, 1024, rem / 8, 2 * (rem % 8) + half, WbrT + (long)l * 1024 * 1024, 1024, 0, 0, 0, smem, tid); continue; }
    u -= N_BRA;
    if (u < N_BRB) { const int l = u / 32, rem = u % 32; transpose_unit(p.w_br_b + (long)l * 256 * 1024, 1024, 0, 1024, rem / 8, 2 * (rem % 8) + half, WbrT + (long)l * 1024 * 1024, 1024, 0, 256, 0, smem, tid); continue; }
    u -= N_BRB;
    if (u < N_BRC) { const int l = u / 64, rem = u % 64; transpose_unit(p.w_br_c + (long)l * 512 * 1024, 1024, 0, 1024, rem / 8, 2 * (rem % 8) + half, WbrT + (long)l * 1024 * 1024, 1024, 0, 512, 0, smem, tid); continue; }
    u -= N_BRC;
    if (u < N_WOUT) { const int l = u / 128, rem = u % 128; transpose_unit(p.w_out + (long)l * 1024 * 1024, 1024, 0, 1024, rem / 8, 2 * (rem % 8) + half, WoutT + (long)l * 1024 * 1024, 1024, 0, 0, 0, smem, tid); continue; }
    u -= N_WOUT;
    if (u < N_POOL) {
      const int idx = u * NTHR + tid;
      const int l = idx >> 16, n = (idx >> 8) & 255, k = idx & 255;
      float v = 0.f;
      if ((n >> 6) == (k >> 6)) v = p.pool_w[(((long)l * 4 + (n >> 6)) * 64 + (k & 63)) * 64 + (n & 63)];
      PoolWt[idx] = f2bf(v);
      continue;
    }
    u -= N_POOL;
    if (u < N_ROPE) {
      const int idx = u * NTHR + tid;
      const int pos = idx >> 5, d = idx & 31, f = d & 7;
      const float base = d < 16 ? (float)(pos >> 6) : (float)(pos & 63);
      const float freq = exp2f(-(float)f * (13.287712379549449f / 8.f));
      float rev = base * freq * 0.15915494309189535f;
      rev -= floorf(rev);
      ROPE[idx] = __builtin_amdgcn_cosf(rev);
      ROPE[4096 * 32 + idx] = __builtin_amdgcn_sinf(rev);
      continue;
    }
    u -= N_ROPE;
    if (u < N_DP) {
      const int id = u * NTHR + tid;
      const int lr = id >> 6, k0 = (id & 63) * 8, part = k0 >= 256, l0 = k0 & 255;
      float v[8];
#pragma unroll
      for (int j = 0; j < 8; ++j) { int n = ((lr * (l0 + j)) & 255) * 16; if (part) n = (n + 1024) & 4095; v[j] = tab[n] * (1.f / 16.f); }
      u32x4 o; o.x = pk_bf16(v[0], v[1]); o.y = pk_bf16(v[2], v[3]); o.z = pk_bf16(v[4], v[5]); o.w = pk_bf16(v[6], v[7]);
      *(u32x4*)(Dp + (long)lr * 512 + k0) = o;
      continue;
    }
    u -= N_DP;
    if (u < N_A1) {
      const int id = u * NTHR + tid;
      const int m = id >> 5, k0 = (id & 31) * 8, pm = (m >> 6) & 1, l1p = m & 63;
      float v[8];
#pragma unroll
      for (int j = 0; j < 8; ++j) {
        const int k = k0 + j, pk = (k >> 6) & 1, l1 = k & 63;
        float val = 0.f;
        if ((k >> 7) == (m >> 7)) {
          int n = ((l1 * l1p) & 63) * 64;
          if (pm != pk) n = (n + (pm == 0 ? 1024 : 3072)) & 4095;
          val = tab[n] * 0.125f;
        }
        v[j] = val;
      }
      u32x4 o; o.x = pk_bf16(v[0], v[1]); o.y = pk_bf16(v[2], v[3]); o.z = pk_bf16(v[4], v[5]); o.w = pk_bf16(v[6], v[7]);
      *(u32x4*)(A1 + (long)m * 256 + k0) = o;
      continue;
    }
    u -= N_A1;
    {
      const int id = u * NTHR + tid;
      const int row = id >> 6, k0 = (id & 63) * 8, qd = row >> 8, m = row & 255;
      const int lp = (4 * qd + (m >> 6)) + 64 * (m & 63);
      float v[8];
#pragma unroll
      for (int e = 0; e < 8; ++e) {
        const int k = k0 + e, blk = k >> 7, part = (k >> 6) & 1, l2 = k & 63;
        float val = 0.f;
        if (blk == (m >> 6)) {
          int n = (l2 * lp) & 4095;
          if (part) n = (n + 1024) & 4095;
          val = tab[n] * 0.125f;
        }
        v[e] = val;
      }
      u32x4 o; o.x = pk_bf16(v[0], v[1]); o.y = pk_bf16(v[2], v[3]); o.z = pk_bf16(v[4], v[5]); o.w = pk_bf16(v[6], v[7]);
      *(u32x4*)(D2 + (long)row * 512 + k0) = o;
    }
  }
}

DI void phase_xn(const Params& p, int l) {
  const int tid = hide_tid();
  const int wave = tid >> 6, lane = tid & 63;
  const float* ng = p.norm_g + l * 1024;
  const float* MODF = (const float*)(p.ws + OFF_MODF) + l * 9216;
  bf16_t* XN = (bf16_t*)(p.ws + OFF_XN);
  for (int row = blockIdx.x * NWAVE + wave; row < NTOK; row += gridDim.x * NWAVE) {
    const float* src = row < NPT ? p.x_prompt + (long)row * 1024 : p.x_sample + (long)(row - NPT) * 1024;
    const bf16_t* srcb = (const bf16_t*)p.out + (long)row * 1024;
    const float* md = MODF + tok_mod_idx(row) * 3072;
    f32x4 x[4];
    float ss = 0.f;
#pragma unroll
    for (int j = 0; j < 4; ++j) {
      if (l == 0) x[j] = *(const f32x4*)(src + j * 256 + lane * 4);
      else { const u32x2 hw = *(const u32x2*)(srcb + j * 256 + lane * 4); x[j] = (f32x4){bf_lo(hw.x), bf_hi(hw.x), bf_lo(hw.y), bf_hi(hw.y)}; }
      ss += x[j][0] * x[j][0] + x[j][1] * x[j][1] + x[j][2] * x[j][2] + x[j][3] * x[j][3];
    }
    ss = wave_sum(ss);
    const float r = rsqrtf(ss * (1.f / 1024.f) + EPS);
#pragma unroll
    for (int j = 0; j < 4; ++j) {
      const int c = j * 256 + lane * 4;
      const f32x4 g = *(const f32x4*)(ng + c), sh = *(const f32x4*)(md + c), sc = *(const f32x4*)(md + 1024 + c);
      float o[4];
#pragma unroll
      for (int e = 0; e < 4; ++e) o[e] = (x[j][e] * r) * g[e] * (1.f + sc[e]) + sh[e];
      u32x2 w; w.x = pk_bf16(o[0], o[1]); w.y = pk_bf16(o[2], o[3]);
      *(u32x2*)(XN + (long)row * LDX + c) = w;
    }
  }
}

struct EpiWin {
  static constexpr bool PERM = true, AFTER_DRAIN = false;
  bf16_t* P; bf16_t* LAT; bf16_t* ATp; bf16_t* Z;
  DI void operator()(const pg8::f32x4 (&acc)[2][2][4][2], const pg8::Unit& u, int wr, int wc, int fr_, int fq_) const {
    int fr = fr_, fq = fq_;
    asm volatile("" : "+v"(fr), "+v"(fq));
#pragma unroll
    for (int bj = 0; bj < 2; ++bj) {
      const int cb = u.pn * 256 + bj * 128 + wc * 32, c0 = cb + 8 * fq;
#pragma unroll
      for (int ai = 0; ai < 2; ++ai)
#pragma unroll
        for (int m = 0; m < 4; ++m) {
          const int row = u.pm * 256 + ai * 128 + wr * 64 + m * 16 + fr;
          const pg8::f32x4 v0 = acc[ai][bj][m][0], v1 = acc[ai][bj][m][1];
          if (cb < 512) {
            const int part = cb >> 8, cc = c0 & 255;
            bf16_t* dst;
            long cst;
            if (row < NPT) { const int b = row >> 8, pos = row & 255; dst = ATp + ((long)b * 256 + cc) * 512 + part * 256 + pos; cst = 512; }
            else { const int rs = row - NPT, b = rs >> 12, pos = rs & 4095; dst = Z + (((long)b * 256 + cc) * 2 + part) * 4096 + pos; cst = 8192; }
#pragma unroll
            for (int e = 0; e < 4; ++e) { dst[(long)e * cst] = f2bf(v0[e]); dst[(long)(4 + e) * cst] = f2bf(v1[e]); }
          } else if (cb >= 1280 && cb < 1696) {
            u32x4 w; w.x = pk_bf16(v0[0], v0[1]); w.y = pk_bf16(v0[2], v0[3]); w.z = pk_bf16(v1[0], v1[1]); w.w = pk_bf16(v1[2], v1[3]);
            *(u32x4*)(LAT + (long)row * LATW + (c0 - 1280)) = w;
          } else if (cb < NEXT) {
            const bool raw = (cb >= 768 && cb < 1024);
            const int pc = c0 < 1280 ? c0 - 512 : c0 - 928;
            float o[8];
#pragma unroll
            for (int e = 0; e < 4; ++e) { o[e] = raw ? v0[e] : silu_f(v0[e]); o[4 + e] = raw ? v1[e] : silu_f(v1[e]); }
            u32x4 w; w.x = pk_bf16(o[0], o[1]); w.y = pk_bf16(o[2], o[3]); w.z = pk_bf16(o[4], o[5]); w.w = pk_bf16(o[6], o[7]);
            *(u32x4*)(P + (long)row * PW + pc) = w;
          }
        }
    }
  }
};
DI void phase_win(const Params& p, int l, unsigned char* smem) {
  pg8::Gemm g{(const bf16_t*)(p.ws + OFF_XN), (const bf16_t*)(p.ws + OFF_WINT) + (long)l * NEXTP * LDX, NTOK, 2048, 1024, LDX, LDX};
  pg8::StaticOrder S;
  S.init(NTOK, 2048, gridDim.x, blockIdx.x);
  EpiWin E{(bf16_t*)(p.ws + OFF_P), (bf16_t*)(p.ws + OFF_LAT), (bf16_t*)(p.ws + OFF_ATP), (bf16_t*)(p.ws + OFF_Z)};
  __syncthreads();
  pg8::gemm_phase<EpiWin, pg8::StaticOrder, true, true>((PG8_LAS unsigned char*)smem, g, S, E);
}

struct TailOrder {
  int c, nwb;
  DI bool next(int i, pg8::Unit& u) const { const int L = i * nwb + c; if (L >= 64) return false; u.pm = L; u.pn = 8; return true; }
  DI void a_ready(const pg8::Unit&) const {}
  DI void done(const pg8::Unit&) const {}
};
DI void phase_win_tail(const Params& p, int l, unsigned char* smem, int nwb) {
  pg8::Gemm g{(const bf16_t*)(p.ws + OFF_XN), (const bf16_t*)(p.ws + OFF_WINT) + (long)l * NEXTP * LDX, NTOK, NEXTP, 1024, LDX, LDX};
  TailOrder S{(int)blockIdx.x, nwb};
  EpiWin E{(bf16_t*)(p.ws + OFF_P), (bf16_t*)(p.ws + OFF_LAT), (bf16_t*)(p.ws + OFF_ATP), (bf16_t*)(p.ws + OFF_Z)};
  __syncthreads();
  pg8::gemm_phase<EpiWin, TailOrder, true, true>((PG8_LAS unsigned char*)smem, g, S, E);
}

DI void phase_lat(const Params& p, int l, int first, int stride) {
  const int tid = hide_tid();
  const int wave = tid >> 6, lane = tid & 63;
  const bf16_t* LAT = (const bf16_t*)(p.ws + OFF_LAT);
  const float* ROPE = (const float*)(p.ws + OFF_ROPE);
  bf16_t* QN = (bf16_t*)(p.ws + OFF_QN);
  bf16_t* CKVB = (bf16_t*)(p.ws + OFF_CKVB);
  bf16_t* KR = (bf16_t*)(p.ws + OFF_KR);
  const float* qg = p.q_norm_g + l * 256;
  const float* kg = p.kv_norm_g + l * 128;
  constexpr int R = 4;
  const int rstep = stride * NWAVE;
  for (int row0 = first * NWAVE + wave; row0 < NROWS_KV; row0 += rstep * R) {
    f32x4 q[R]; f32x2 kv[R]; float kr[R], cs[R], sn[R];
#pragma unroll
    for (int i = 0; i < R; ++i) {
      const int row = min(row0 + i * rstep, NROWS_KV - 1);
      q[i] = (f32x4){0.f, 0.f, 0.f, 0.f}; cs[i] = 0.f; sn[i] = 0.f;
      if (row < NTOK) {
        const bf16_t* src = LAT + (long)row * LATW;
        { const u32x2 w = *(const u32x2*)(src + lane * 4); q[i] = (f32x4){bf_lo(w.x), bf_hi(w.x), bf_lo(w.y), bf_hi(w.y)}; }
        { const unsigned w = *(const unsigned*)(src + 256 + lane * 2); kv[i] = (f32x2){bf_lo(w), bf_hi(w)}; }
        kr[i] = lane < 32 ? bf2f_(src[384 + lane]) : 0.f;
        if (row >= NPT && lane < 32) { const int pos = (row - NPT) & 4095; cs[i] = ROPE[pos * 32 + lane]; sn[i] = ROPE[4096 * 32 + pos * 32 + lane]; }
      } else {
        const int cr = row - NTOK, b = cr >> 9, pp = cr & 511;
        kv[i] = *(const f32x2*)(p.cache_ckv + ((long)(b * 2 + l) * 512 + pp) * 128 + lane * 2);
        kr[i] = lane < 32 ? p.cache_krope[((long)(b * 2 + l) * 512 + pp) * 32 + lane] : 0.f;
      }
    }
    const f32x4 g = *(const f32x4*)(qg + lane * 4);
    const f32x2 g2 = *(const f32x2*)(kg + lane * 2);
#pragma unroll
    for (int i = 0; i < R; ++i) {
      const int row = row0 + i * rstep;
      if (row >= NROWS_KV) break;
      if (row < NTOK) {
        float ssq = wave_sum(q[i][0] * q[i][0] + q[i][1] * q[i][1] + q[i][2] * q[i][2] + q[i][3] * q[i][3]);
        float ssk = wave_sum(kv[i][0] * kv[i][0] + kv[i][1] * kv[i][1]);
        const float rq = rsqrtf(ssq * (1.f / 256.f) + EPS), rk = rsqrtf(ssk * (1.f / 128.f) + EPS);
        u32x2 w; w.x = pk_bf16(q[i][0] * rq * g[0], q[i][1] * rq * g[1]); w.y = pk_bf16(q[i][2] * rq * g[2], q[i][3] * rq * g[3]);
        *(u32x2*)(QN + (long)row * 256 + lane * 4) = w;
        const float c0 = kv[i][0] * rk * g2[0], c1 = kv[i][1] * rk * g2[1];
        *(unsigned*)(CKVB + (long)row * 128 + lane * 2) = pk_bf16(c0, c1);
        if (row < NPT) {
          const int b = row >> 8, s = row & 255;
          const long o = ((long)(b * 2 + l) * 256 + s);
          f32x2 cv = {c0, c1};
          *(f32x2*)(p.out + OUT_CKV + o * 128 + lane * 2) = cv;
          if (lane < 32) {
            p.out[OUT_KR + o * 32 + lane] = kr[i];
            KR[(long)row * 32 + lane] = f2bf(kr[i]);
          }
        } else {
          const int rs = row - NPT, b = rs >> 12, pos = rs & 4095;
          const float partner = __shfl_xor(kr[i], 8);
          if (lane < 32) {
            const float rx = (lane & 8) ? partner : -partner;
            KR[((long)NPT + (long)b * LKS + pos) * 32 + lane] = f2bf(kr[i] * cs[i] + rx * sn[i]);
          }
        }
      } else {
        const int cr = row - NTOK, b = cr >> 9, pp = cr & 511;
        *(unsigned*)(CKVB + (long)row * 128 + lane * 2) = pk_bf16(kv[i][0], kv[i][1]);
        if (lane < 32) KR[((long)NPT + (long)b * LKS + 4096 + pp) * 32 + lane] = f2bf(kr[i]);
      }
    }
  }
}

template <int W> DI void pool_item(const bf16_t* __restrict__ P, bf16_t* __restrict__ PB, int t, int ch) {
  constexpr int left = W / 2, right = W - 1 - left;
  int s0, L;
  if (t < NPT) { s0 = t & ~255; L = 256; } else { s0 = NPT + ((t - NPT) & ~4095); L = 4096; }
  const int tt = t - s0;
  u32x4 v[W];
#pragma unroll
  for (int j = 0; j < W; ++j) {
    int idx = tt - left + j;
    idx = idx < 0 ? 0 : (idx > L - 1 ? L - 1 : idx);
    v[j] = *(const u32x4*)(P + (long)(s0 + idx) * PW + PC_BIN + ch * 8);
  }
  float sum[8];
#pragma unroll
  for (int e = 0; e < 8; ++e) sum[e] = 0.f;
#pragma unroll
  for (int j = 0; j < W; ++j) {
    const int idx = tt - left + j;
    const float m = (idx >= 0 && idx < L) ? 1.f : 0.f;
    sum[0] += m * bf_lo(v[j].x); sum[1] += m * bf_hi(v[j].x); sum[2] += m * bf_lo(v[j].y); sum[3] += m * bf_hi(v[j].y);
    sum[4] += m * bf_lo(v[j].z); sum[5] += m * bf_hi(v[j].z); sum[6] += m * bf_lo(v[j].w); sum[7] += m * bf_hi(v[j].w);
  }
  const int lo = max(tt - left, 0), hi = min(tt + right, L - 1);
  const u32x4 c = v[left];
  const float inv = 1.f / (float)(hi - lo + 1);
  u32x4 o;
  o.x = pk_bf16(sum[0] * inv - bf_lo(c.x), sum[1] * inv - bf_hi(c.x));
  o.y = pk_bf16(sum[2] * inv - bf_lo(c.y), sum[3] * inv - bf_hi(c.y));
  o.z = pk_bf16(sum[4] * inv - bf_lo(c.z), sum[5] * inv - bf_hi(c.z));
  o.w = pk_bf16(sum[6] * inv - bf_lo(c.w), sum[7] * inv - bf_hi(c.w));
  *(u32x4*)(PB + (long)t * 256 + ch * 8) = o;
}
DI void phase_up(const Params& p, int l, unsigned char* smem) {
  const int tid_outer = hide_tid();
  const bf16_t* QN = (const bf16_t*)(p.ws + OFF_QN);
  const bf16_t* CKVB = (const bf16_t*)(p.ws + OFF_CKVB);
  const bf16_t* WqT = (const bf16_t*)(p.ws + OFF_WQT) + (long)l * 768 * 256;
  const bf16_t* WkvT = (const bf16_t*)(p.ws + OFF_WKVT) + (long)l * 1024 * 128;
  const float* ROPE = (const float*)(p.ws + OFF_ROPE);
  bf16_t* Q = (bf16_t*)(p.ws + OFF_Q);
  bf16_t* Kp = (bf16_t*)(p.ws + OFF_KP);
  bf16_t* Ks = (bf16_t*)(p.ws + OFF_KS);
  bf16_t* Vtp = (bf16_t*)(p.ws + OFF_VTP);
  bf16_t* Vts = (bf16_t*)(p.ws + OFF_VTS);
  const bf16_t* P = (const bf16_t*)(p.ws + OFF_P);
  bf16_t* PB = (bf16_t*)(p.ws + OFF_PB);
  const int N_Q = 64 * 3, N_KV = 68 * 4;
  const int total = N_Q + N_KV;
  const int tid0 = tid_outer;
  for (int u0 = virt_block(); u0 < total; u0 += gridDim.x) {
    int tid = tid0;
    asm volatile("" : "+v"(tid));
    int u = u0;
    if (u < N_Q) {
      int mt, nt;
      tile_decode(u, 3, mt, nt);
      f32x16 acc[4][2];
      acc_zero(acc);
      gemm_main(tid, QN + (long)mt * 256 * 256, 256, WqT + (long)nt * 256 * 256, 256, 256, acc, smem);
      epi_blocks(tid, acc, mt * 256, nt * 256, [&](int row, int cb, int hh, const f32x16& a) {
        const int head = cb / 96, j0 = cb % 96;
        bf16_t* d;
        int pos = 0;
        const bool samp = row >= NPT;
        if (!samp) { const int b = row >> 8; pos = row & 255; d = Q + ((long)(b * 8 + head) * 256 + pos) * 96 + j0 + 4 * hh; }
        else { const int rs = row - NPT, b = rs >> 12; pos = rs & 4095; d = Q + (long)NPT * 768 + ((long)(b * 8 + head) * 4096 + pos) * 96 + j0 + 4 * hh; }
        float v[16];
#pragma unroll
        for (int i = 0; i < 16; ++i) v[i] = a[i];
        if (samp && j0 == 64) {
#pragma unroll
          for (int gp = 0; gp < 2; ++gp) {
            const f32x4 cs = *(const f32x4*)(ROPE + pos * 32 + 16 * gp + 4 * hh);
            const f32x4 sn = *(const f32x4*)(ROPE + 4096 * 32 + pos * 32 + 16 * gp + 4 * hh);
#pragma unroll
            for (int e = 0; e < 4; ++e) {
              const float x0 = a[8 * gp + e], x1 = a[8 * gp + 4 + e];
              v[8 * gp + e] = x0 * cs[e] - x1 * sn[e];
              v[8 * gp + 4 + e] = x1 * cs[e] + x0 * sn[e];
            }
          }
        }
#pragma unroll
        for (int g = 0; g < 4; ++g) {
          u32x2 w; w.x = pk_bf16(v[4 * g] * QSCALE, v[4 * g + 1] * QSCALE); w.y = pk_bf16(v[4 * g + 2] * QSCALE, v[4 * g + 3] * QSCALE);
          *(u32x2*)(d + 8 * g) = w;
        }
      });
      continue;
    }
    u -= N_Q;
    if (u < N_KV) {
      const int mt = u >> 2, nt = u & 3;
      f32x16 acc[4][2];
      acc_zero(acc);
      gemm_main(tid, CKVB + (long)mt * 256 * 128, 128, WkvT + (long)nt * 256 * 128, 128, 128, acc, smem);
      epi_blocks(tid, acc, mt * 256, nt * 256, [&](int row, int cb, int hh, const f32x16& a) {
        const int head = cb >> 7, j0 = cb & 127;
        const bool samp = row >= NPT;
        int b, pos;
        if (!samp) { b = row >> 8; pos = row & 255; }
        else if (row < NTOK) { const int rs = row - NPT; b = rs >> 12; pos = rs & 4095; }
        else { const int cr = row - NTOK; b = cr >> 9; pos = 4096 + (cr & 511); }
        const int Lk = samp ? LKS : 256;
        const size_t kofs = samp ? OFF_KS : OFF_KP, vofs = samp ? OFF_VTS : OFF_VTP;
        bf16_t* kbase = (bf16_t*)(p.ws + kofs) + (long)(b * 8 + head) * Lk * 64;
        bf16_t* vbase = (bf16_t*)(p.ws + vofs) + (long)(b * 8 + head) * 64 * Lk;
        if (j0 < 64) {
          bf16_t* d = kbase + (long)pos * 64 + j0 + 4 * hh;
#pragma unroll
          for (int g = 0; g < 4; ++g) { u32x2 w; w.x = pk_bf16(a[4 * g], a[4 * g + 1]); w.y = pk_bf16(a[4 * g + 2], a[4 * g + 3]); *(u32x2*)(d + 8 * g) = w; }
        } else {
          bf16_t* d = vbase + (long)(j0 - 64 + 4 * hh) * Lk + pos;
#pragma unroll
          for (int i = 0; i < 16; ++i) d[(long)((i & 3) + 8 * (i >> 2)) * Lk] = f2bf(a[i]);
        }
      });
      continue;
    }
  }
}

DI void phase_aux(const Params& p, int l, unsigned char* smem, int first, int stride) {
  const int tid_outer = hide_tid();
  const bf16_t* P = (const bf16_t*)(p.ws + OFF_P);
  bf16_t* PB = (bf16_t*)(p.ws + OFF_PB);
  const int N_F1 = 128, N_POOL = 1024;
  const int total = N_F1 + N_POOL;
  const int tid0 = tid_outer;
  for (int u0 = first; u0 < total; u0 += stride) {
    int tid = tid0;
    asm volatile("" : "+v"(tid));
    int u = u0;
    if (u < N_F1) {
      const int b = u >> 6, cg = u & 63;
      const bf16_t* A1 = (const bf16_t*)(p.ws + OFF_A1);
      const bf16_t* Zs = (const bf16_t*)(p.ws + OFF_Z) + ((long)(b * 256 + 4 * cg) * 2) * 4096;
      bf16_t* Y1 = (bf16_t*)(p.ws + OFF_Y1) + ((long)(b * 256 + 4 * cg) * 64) * 128;
      f32x16 acc[4][2];
      acc_zero(acc);
      __syncthreads();
      gemm_dma_b(tid, A1, 256, 0, smem);
      gemm_dma_b(tid, A1, 256, 64, smem + GM_STAGE);
#pragma unroll
      for (int part = 0; part < 2; ++part)
#pragma unroll
        for (int it = 0; it < 4; ++it) {
          const int item = tid + NTHR * it, l2c = item & 7, l1 = (item >> 3) & 63, cl = item >> 9;
          const u32x4 v = *(const u32x4*)(Zs + ((long)(cl * 2 + part)) * 4096 + l1 * 64 + l2c * 8);
          const unsigned w[4] = {v.x, v.y, v.z, v.w};
          unsigned char* st = smem + part * GM_STAGE;
#pragma unroll
          for (int e = 0; e < 8; ++e) {
            const int m = cl * 64 + l2c * 8 + e;
            const unsigned hv = (e & 1) ? (w[e >> 1] >> 16) : (w[e >> 1] & 0xffffu);
            *(bf16_t*)(st + m * 128 + (((l1 >> 3) ^ ((m >> 1) & 7)) << 4) + (l1 & 7) * 2) = (bf16_t)hv;
          }
        }
      asm volatile("s_waitcnt vmcnt(0)" ::: "memory");
      __syncthreads();
      gemm_compute(tid, smem, acc);
      gemm_compute(tid, smem + GM_STAGE, acc);
      __syncthreads();
      epi_blocks(tid, acc, 0, 0, [&](int row, int cb, int hh, const f32x16& a) {
        if (cb < 128) {
          bf16_t* d = Y1 + ((long)(row >> 6) * 64) * 128 + (row & 63);
#pragma unroll
          for (int i = 0; i < 16; ++i) { const int n = cb + (i & 3) + 8 * (i >> 2) + 4 * hh; d[(long)(n & 63) * 128 + (n >> 6) * 64] = f2bf(a[i]); }
        }
      });
      continue;
    }
    u -= N_F1;
    {
      const int id = u * NTHR + tid;
      const int gi = (id >> 6) & 3, t = ((id >> 8) << 3) | ((id >> 3) & 7), ch = gi * 8 + (id & 7);
      if (gi == 0) pool_item<2>(P, PB, t, ch);
      else if (gi == 1) pool_item<4>(P, PB, t, ch);
      else if (gi == 2) pool_item<8>(P, PB, t, ch);
      else pool_item<16>(P, PB, t, ch);
    }
  }
}

constexpr int ATT_KSTR = 208, ATT_VSTR = 144, ATT_VOFF = 64 * ATT_KSTR, ATT_STAGE = ATT_VOFF + 64 * ATT_VSTR;
DI void attn_load_g(int tid, const bf16_t* __restrict__ Kn, const bf16_t* __restrict__ Kr, const bf16_t* __restrict__ Vt, int Lk, int kt, u32x4 (&rk)[2], u32x4& rv) {
  rk[0] = *(const u32x4*)(Kn + (long)kt * 64 * 64 + (long)tid * 8);
  if (tid < 256) rk[1] = *(const u32x4*)(Kr + (long)kt * 64 * 32 + (long)tid * 8);
  { const int dv = tid >> 3, part = tid & 7; rv = *(const u32x4*)(Vt + (long)dv * Lk + kt * 64 + part * 8); }
}
DI void attn_store_l(int tid, unsigned char* st, const u32x4 (&rk)[2], const u32x4& rv) {
  { const int key = tid >> 3, part = tid & 7; *(u32x4*)(st + key * ATT_KSTR + part * 16) = rk[0]; }
  if (tid < 256) { const int key = tid >> 2, part = 8 + (tid & 3); *(u32x4*)(st + key * ATT_KSTR + part * 16) = rk[1]; }
  {
    const int dv = tid >> 3, part = tid & 7;
    unsigned char* d = st + ATT_VOFF + dv * ATT_VSTR + ((part >> 1) * 16 + (part & 1) * 4) * 2;
    u32x2 lo = {rv.x, rv.y}, hi = {rv.z, rv.w};
    *(u32x2*)d = lo;
    *(u32x2*)(d + 16) = hi;
  }
}
DI void attn_unit(const Params& p, int kind, int idx, unsigned char* smem, int tid) {
  int Lq, Lk, b, h, qb, tokbase;
  const bf16_t *Q, *Kn, *Kr, *Vt;
  if (kind) {
    Lq = 4096; Lk = LKS; qb = idx & 15; h = (idx >> 4) & 7; b = idx >> 7; tokbase = NPT + b * 4096;
    Q = (const bf16_t*)(p.ws + OFF_Q) + (long)NPT * 768 + ((long)(b * 8 + h) * Lq + qb * 256) * 96;
    Kn = (const bf16_t*)(p.ws + OFF_KS) + (long)(b * 8 + h) * Lk * 64;
    Kr = (const bf16_t*)(p.ws + OFF_KR) + ((long)NPT + (long)b * LKS) * 32;
    Vt = (const bf16_t*)(p.ws + OFF_VTS) + (long)(b * 8 + h) * 64 * Lk;
  } else {
    Lq = 256; Lk = 256; qb = 0; h = idx & 7; b = idx >> 3; tokbase = b * 256;
    Q = (const bf16_t*)(p.ws + OFF_Q) + ((long)(b * 8 + h) * Lq) * 96;
    Kn = (const bf16_t*)(p.ws + OFF_KP) + (long)(b * 8 + h) * Lk * 64;
    Kr = (const bf16_t*)(p.ws + OFF_KR) + (long)b * 256 * 32;
    Vt = (const bf16_t*)(p.ws + OFF_VTP) + (long)(b * 8 + h) * 64 * Lk;
  }
  const int wave = tid >> 6, lane = tid & 63, r = lane & 31, hh = lane >> 5;
  bf16x8 qf[6];
#pragma unroll
  for (int s = 0; s < 6; ++s) qf[s] = *(const bf16x8*)(Q + (long)(wave * 32 + r) * 96 + 16 * s + 8 * hh);
  f32x16 O[2];
#pragma unroll
  for (int i = 0; i < 16; ++i) { O[0][i] = 0.f; O[1][i] = 0.f; }
  float m = 0.f, lsum = 0.f;
  u32x4 rk0[2], rv0, rk1[2], rv1;
  const int nkt = Lk >> 6;
  attn_load_g(tid, Kn, Kr, Vt, Lk, 0, rk0, rv0);
  attn_load_g(tid, Kn, Kr, Vt, Lk, 1, rk1, rv1);
  attn_store_l(tid, smem, rk0, rv0);
  __syncthreads();
  auto tile = [&](const unsigned char* st) {
    f32x16 S[2];
    const float negm = -m;
#pragma unroll
    for (int kb = 0; kb < 2; ++kb) {
#pragma unroll
      for (int i = 0; i < 16; ++i) S[kb][i] = negm;
#pragma unroll
      for (int s = 0; s < 6; ++s) {
        const bf16x8 kf = *(const bf16x8*)(st + (kb * 32 + r) * ATT_KSTR + (16 * s + 8 * hh) * 2);
        S[kb] = __builtin_amdgcn_mfma_f32_32x32x16_bf16(kf, qf[s], S[kb], 0, 0, 0);
      }
    }
    float mx = fmaxf(fmaxf(S[0][0], S[0][1]), S[0][2]);
#pragma unroll
    for (int i = 3; i < 15; i += 2) mx = fmaxf(fmaxf(mx, S[0][i]), S[0][i + 1]);
    mx = fmaxf(mx, S[0][15]);
#pragma unroll
    for (int i = 0; i < 16; i += 2) mx = fmaxf(fmaxf(mx, S[1][i]), S[1][i + 1]);
    mx = fmaxf(mx, __shfl_xor(mx, 32));
    if (__builtin_amdgcn_ballot_w64(mx > 0.f) != 0ull) {
      const float delta = fmaxf(mx, 0.f);
      const float alpha = __builtin_amdgcn_exp2f(-delta);
      m += delta;
      lsum *= alpha;
#pragma unroll
      for (int i = 0; i < 16; ++i) { O[0][i] *= alpha; O[1][i] *= alpha; S[0][i] -= delta; S[1][i] -= delta; }
    }
    float ps = 0.f;
#pragma unroll
    for (int kb = 0; kb < 2; ++kb)
#pragma unroll
      for (int i = 0; i < 16; ++i) { const float e = __builtin_amdgcn_exp2f(S[kb][i]); S[kb][i] = e; ps += e; }
    lsum += ps;
#pragma unroll
    for (int kb = 0; kb < 2; ++kb)
#pragma unroll
      for (int s = 0; s < 2; ++s) {
        u32x4 pw;
        pw.x = pk_bf16(S[kb][8 * s + 0], S[kb][8 * s + 1]); pw.y = pk_bf16(S[kb][8 * s + 2], S[kb][8 * s + 3]);
        pw.z = pk_bf16(S[kb][8 * s + 4], S[kb][8 * s + 5]); pw.w = pk_bf16(S[kb][8 * s + 6], S[kb][8 * s + 7]);
        const bf16x8 pf = __builtin_bit_cast(bf16x8, pw);
#pragma unroll
        for (int dvb = 0; dvb < 2; ++dvb) {
          const bf16x8 vf = *(const bf16x8*)(st + ATT_VOFF + (dvb * 32 + r) * ATT_VSTR + (kb * 32 + 16 * s + 8 * hh) * 2);
          O[dvb] = __builtin_amdgcn_mfma_f32_32x32x16_bf16(vf, pf, O[dvb], 0, 0, 0);
        }
      }
  };
  for (int kt = 0; kt < nkt; kt += 2) {
    if (kt + 2 < nkt) attn_load_g(tid, Kn, Kr, Vt, Lk, kt + 2, rk0, rv0);
    __builtin_amdgcn_sched_barrier(0);
    tile(smem);
    __builtin_amdgcn_sched_barrier(0);
    attn_store_l(tid, smem + ATT_STAGE, rk1, rv1);
    __syncthreads();
    if (kt + 3 < nkt) attn_load_g(tid, Kn, Kr, Vt, Lk, kt + 3, rk1, rv1);
    __builtin_amdgcn_sched_barrier(0);
    tile(smem + ATT_STAGE);
    __builtin_amdgcn_sched_barrier(0);
    if (kt + 2 < nkt) attn_store_l(tid, smem, rk0, rv0);
    __syncthreads();
  }
  lsum += __shfl_xor(lsum, 32);
  const float inv = 1.f / lsum;
  const int t = tokbase + qb * 256 + wave * 32 + r;
  const bf16_t* gate = (const bf16_t*)(p.ws + OFF_P) + (long)t * PW + PC_CZ + h * 64 + 4 * hh;
  bf16_t* dst = (bf16_t*)(p.ws + OFF_X) + (long)t * 1024 + 512 + h * 64 + 4 * hh;
#pragma unroll
  for (int dvb = 0; dvb < 2; ++dvb)
#pragma unroll
    for (int g = 0; g < 4; ++g) {
      const u32x2 gv = *(const u32x2*)(gate + dvb * 32 + 8 * g);
      u32x2 w;
      w.x = pk_bf16(O[dvb][4 * g] * inv * bf_lo(gv.x), O[dvb][4 * g + 1] * inv * bf_hi(gv.x));
      w.y = pk_bf16(O[dvb][4 * g + 2] * inv * bf_lo(gv.y), O[dvb][4 * g + 3] * inv * bf_hi(gv.y));
      *(u32x2*)(dst + dvb * 32 + 8 * g) = w;
    }
}

DI void phase_mix(const Params& p, int l, unsigned char* smem) {
  const int tid_outer = hide_tid();
  unsigned* ctr = (unsigned*)(p.ws + OFF_CTR) + l;
  __shared__ int s_unit;
  const bf16_t* P = (const bf16_t*)(p.ws + OFF_P);
  bf16_t* X = (bf16_t*)(p.ws + OFF_X);
  const int total = 640;
  int hu = virt_block();
  const int tid0 = tid_outer;
  while (true) {
    int tid = tid0;
    asm volatile("" : "+v"(tid));
    int u;
    if (hu < 256) { u = hu; hu += gridDim.x; }
    else {
      __syncthreads();
      if (tid == 0) s_unit = 256 + (int)atomicAdd(ctr, 1u);
      __syncthreads();
      u = s_unit;
      if (u >= total) break;
      u = u < 256 + 128 ? u + 256 : u - 128;
    }
    if (u < 512) {
      const int kind = u < 256 ? 1 : 0;
      attn_unit(p, kind, kind ? u : u - 256, smem, tid);
      continue;
    }
    const bf16_t *A, *Bt;
    long lda, ldb;
    int K, tokbase, fq = -1, gcol, xcol;
    const float* sc = nullptr;
    if (u < 544) {
      const int v = u - 512, b = v >> 4;
      fq = v & 15; lda = 8192; ldb = 512; K = 512; tokbase = NPT + b * 4096 + 4 * fq; gcol = PC_AZ; xcol = 0;
      A = (const bf16_t*)(p.ws + OFF_Y1) + (((long)b * 256) * 64 + 4 * fq) * 128;
      Bt = (const bf16_t*)(p.ws + OFF_D2) + (long)fq * 256 * 512;
    } else if (u < 576) {
      const int b = u - 544;
      lda = 512; ldb = 512; K = 512; tokbase = b * 256; gcol = PC_AZ; xcol = 0;
      A = (const bf16_t*)(p.ws + OFF_DP);
      Bt = (const bf16_t*)(p.ws + OFF_ATP) + (long)b * 256 * 512;
    } else {
      const int mt = u - 576;
      lda = 256; ldb = 256; K = 256; tokbase = mt * 256; gcol = PC_BZ; xcol = 256;
      A = (const bf16_t*)(p.ws + OFF_PB) + (long)mt * 256 * 256;
      Bt = (const bf16_t*)(p.ws + OFF_POOLWT) + (long)l * 65536;
      sc = p.pool_scale + l * 256;
    }
    f32x16 acc[4][2];
    acc_zero(acc);
    gemm_main(tid, A, lda, Bt, ldb, K, acc, smem, fq >= 0 ? 2 : (sc ? 1 : 0));
    if (fq >= 0) {
      epi_blocks(tid, acc, 0, 0, [&](int row, int cb, int hh, const f32x16& a) {
#pragma unroll
        for (int i = 0; i < 16; ++i) {
          const int n = cb + (i & 3) + 8 * (i >> 2) + 4 * hh;
          const long t = tokbase + (n >> 6) + 64 * (n & 63);
          X[t * 1024 + row] = f2bf(a[i] * bf2f_(P[t * PW + PC_AZ + row]));
          asm volatile("" ::: "memory");
        }
      });
      continue;
    }
    epi_blocks(tid, acc, 0, 0, [&](int row, int cb, int hh, const f32x16& a) {
      const long t = (long)tokbase + row;
      const bf16_t* gp = P + t * PW + gcol + cb + 4 * hh;
      bf16_t* d = X + t * 1024 + xcol + cb + 4 * hh;
#pragma unroll
      for (int g = 0; g < 4; ++g) {
        const u32x2 gv = *(const u32x2*)(gp + 8 * g);
        f32x4 s4 = {1.f, 1.f, 1.f, 1.f};
        if (sc) s4 = *(const f32x4*)(sc + cb + 4 * hh + 8 * g);
        u32x2 w;
        w.x = pk_bf16(a[4 * g] * s4[0] * bf_lo(gv.x), a[4 * g + 1] * s4[1] * bf_hi(gv.x));
        w.y = pk_bf16(a[4 * g + 2] * s4[2] * bf_lo(gv.y), a[4 * g + 3] * s4[3] * bf_hi(gv.y));
        *(u32x2*)(d + 8 * g) = w;
      }
    });
  }
}

DI size_t gate_image_ofs(int seg) { return seg == 0 ? OFF_G : (seg == 1 ? OFF_P : OFF_KS); }
struct GateOrder {
  int pm, pn;
  DI bool next(int i, pg8::Unit& u) const { if (i >= 3) return false; u.pm = pm; u.pn = i * 4 + pn; return true; }
  DI void a_ready(const pg8::Unit&) const {}
  DI void done(const pg8::Unit&) const {}
};
struct EpiGate {
  static constexpr bool PERM = true, AFTER_DRAIN = false;
  unsigned char* ws;
  DI void operator()(const pg8::f32x4 (&acc)[2][2][4][2], const pg8::Unit& u, int wr, int wc, int fr_, int fq_) const {
    int fr = fr_, fq = fq_;
    asm volatile("" : "+v"(fr), "+v"(fq));
    bf16_t* G = (bf16_t*)(ws + gate_image_ofs(u.pn >> 2));
    const int pnl = u.pn & 3;
#pragma unroll
    for (int bj = 0; bj < 2; ++bj)
#pragma unroll
      for (int ai = 0; ai < 2; ++ai)
#pragma unroll
        for (int m = 0; m < 4; ++m) {
          const int row = u.pm * 256 + ai * 128 + wr * 64 + m * 16 + fr, c0 = pnl * 256 + bj * 128 + wc * 32 + 8 * fq;
          const pg8::f32x4 v0 = acc[ai][bj][m][0], v1 = acc[ai][bj][m][1];
          u32x4 w; w.x = pk_bf16(sigmoid_f(v0[0]), sigmoid_f(v0[1])); w.y = pk_bf16(sigmoid_f(v0[2]), sigmoid_f(v0[3]));
          w.z = pk_bf16(sigmoid_f(v1[0]), sigmoid_f(v1[1])); w.w = pk_bf16(sigmoid_f(v1[2]), sigmoid_f(v1[3]));
          (void)row; (void)c0;
          *(u32x4*)(G + ((long)((u.pm * 4 + pnl) * 16 + (bj * 2 + ai) * 4 + m) * 512 + ((wr * 4 + wc) * 64 + fq * 16 + fr)) * 8) = w;
        }
  }
};
struct EpiBranch {
  static constexpr bool PERM = true, AFTER_DRAIN = false;
  unsigned char* ws; bf16_t* Y;
  DI void operator()(const pg8::f32x4 (&acc)[2][2][4][2], const pg8::Unit& u, int wr, int wc, int fr_, int fq_) const {
    int fr = fr_, fq = fq_;
    asm volatile("" : "+v"(fr), "+v"(fq));
    const int seg = u.koff == 0 ? 0 : (u.koff == 256 ? 1 : 2);
    const bf16_t* G = (const bf16_t*)(ws + gate_image_ofs(seg));
    bf16_t* YT = (bf16_t*)(ws + gate_image_ofs(0));
#pragma unroll
    for (int bj = 0; bj < 2; ++bj)
#pragma unroll
      for (int ai = 0; ai < 2; ++ai)
#pragma unroll
        for (int m = 0; m < 4; ++m) {
          const int row = u.pm * 256 + ai * 128 + wr * 64 + m * 16 + fr, c0 = u.pn * 256 + bj * 128 + wc * 32 + 8 * fq;
          const pg8::f32x4 v0 = acc[ai][bj][m][0], v1 = acc[ai][bj][m][1];
          const long tm = ((long)((u.pm * 4 + u.pn) * 16 + (bj * 2 + ai) * 4 + m) * 512 + ((wr * 4 + wc) * 64 + fq * 16 + fr)) * 8;
          const u32x4 gv = *(const u32x4*)(G + tm);
          u32x4 yv = {0u, 0u, 0u, 0u};
          if (seg > 0) yv = *(const u32x4*)(YT + tm);
          u32x4 w;
          w.x = pk_bf16(bf_lo(yv.x) + v0[0] * bf_lo(gv.x), bf_hi(yv.x) + v0[1] * bf_hi(gv.x));
          w.y = pk_bf16(bf_lo(yv.y) + v0[2] * bf_lo(gv.y), bf_hi(yv.y) + v0[3] * bf_hi(gv.y));
          w.z = pk_bf16(bf_lo(yv.z) + v1[0] * bf_lo(gv.z), bf_hi(yv.z) + v1[1] * bf_hi(gv.z));
          w.w = pk_bf16(bf_lo(yv.w) + v1[2] * bf_lo(gv.w), bf_hi(yv.w) + v1[3] * bf_hi(gv.w));
          if (seg < 2) *(u32x4*)(YT + tm) = w;
          else *(u32x4*)(Y + (long)row * 1024 + c0) = w;
        }
  }
};
DI void phase_merge(const Params& p, int l, unsigned char* smem) {
  const bf16_t* X = (const bf16_t*)(p.ws + OFF_X);
  const bf16_t* XN = (const bf16_t*)(p.ws + OFF_XN);
  const bf16_t* WbrT = (const bf16_t*)(p.ws + OFF_WBRT) + (long)l * 1024 * 1024;
  const bf16_t* WgT = (const bf16_t*)(p.ws + OFF_WGT) + (long)l * 3072 * LDX;
  bf16_t* Y = (bf16_t*)(p.ws + OFF_Y);
  pg8::StaticOrder S;
  S.init(NTOK, 1024, gridDim.x, blockIdx.x);
  pg8::Unit tile;
#pragma unroll 1
  for (int ti = 0; S.next(ti, tile); ++ti) {
    {
      pg8::Gemm g{XN, WgT, NTOK, 3072, 1024, LDX, LDX};
      GateOrder O{tile.pm, tile.pn};
      EpiGate E{p.ws};
      __syncthreads();
      pg8::gemm_phase<EpiGate, GateOrder, true, true>((PG8_LAS unsigned char*)smem, g, O, E);
    }
    {
      pg8::Gemm g{X, WbrT, NTOK, 1024, 256, 1024, 1024};
      struct BranchOrder {
        int pm, pn;
        DI bool next(int i, pg8::Unit& u) const { if (i >= 3) return false; u.pm = pm; u.pn = pn; u.koff = i * 256; u.K = i == 2 ? 512 : 256; return true; }
        DI void a_ready(const pg8::Unit&) const {}
        DI void done(const pg8::Unit&) const {}
      } O{tile.pm, tile.pn};
      EpiBranch E{p.ws, Y};
      __syncthreads();
      pg8::gemm_phase<EpiBranch, BranchOrder, true, true>((PG8_LAS unsigned char*)smem, g, O, E);
    }
  }
}

struct EpiWout {
  static constexpr bool PERM = true, AFTER_DRAIN = false;
  const float* x_prompt; const float* x_sample; const bf16_t* hb_in; bf16_t* hb_out; const float* MODF; int l;
  DI void operator()(const pg8::f32x4 (&acc)[2][2][4][2], const pg8::Unit& u, int wr, int wc, int fr_, int fq_) const {
    int fr = fr_, fq = fq_;
    asm volatile("" : "+v"(fr), "+v"(fq));
#pragma unroll
    for (int bj = 0; bj < 2; ++bj)
#pragma unroll
      for (int ai = 0; ai < 2; ++ai)
#pragma unroll
        for (int m = 0; m < 4; ++m) {
          const int row = u.pm * 256 + ai * 128 + wr * 64 + m * 16 + fr, c0 = u.pn * 256 + bj * 128 + wc * 32 + 8 * fq;
          const float* gt = MODF + tok_mod_idx(row) * 3072 + 2048 + c0;
          float hv[8];
          if (l == 0) {
            const float* hp = (row < NPT ? x_prompt + (long)row * 1024 : x_sample + (long)(row - NPT) * 1024) + c0;
            const f32x4 h0 = *(const f32x4*)hp, h1 = *(const f32x4*)(hp + 4);
#pragma unroll
            for (int e = 0; e < 4; ++e) { hv[e] = h0[e]; hv[4 + e] = h1[e]; }
          } else {
            const u32x4 hw = *(const u32x4*)(hb_in + (long)row * 1024 + c0);
            hv[0] = bf_lo(hw.x); hv[1] = bf_hi(hw.x); hv[2] = bf_lo(hw.y); hv[3] = bf_hi(hw.y);
            hv[4] = bf_lo(hw.z); hv[5] = bf_hi(hw.z); hv[6] = bf_lo(hw.w); hv[7] = bf_hi(hw.w);
          }
          const f32x4 g0 = *(const f32x4*)gt, g1 = *(const f32x4*)(gt + 4);
          const pg8::f32x4 v0 = acc[ai][bj][m][0], v1 = acc[ai][bj][m][1];
          u32x4 w;
          w.x = pk_bf16(hv[0] + g0[0] * v0[0], hv[1] + g0[1] * v0[1]); w.y = pk_bf16(hv[2] + g0[2] * v0[2], hv[3] + g0[3] * v0[3]);
          w.z = pk_bf16(hv[4] + g1[0] * v1[0], hv[5] + g1[1] * v1[1]); w.w = pk_bf16(hv[6] + g1[2] * v1[2], hv[7] + g1[3] * v1[3]);
          *(u32x4*)(hb_out + (long)row * 1024 + c0) = w;
        }
  }
};
DI void phase_wout(const Params& p, int l, unsigned char* smem) {
  pg8::Gemm g{(const bf16_t*)(p.ws + OFF_Y), (const bf16_t*)(p.ws + OFF_WOUTT) + (long)l * 1024 * 1024, NTOK, 1024, 1024, 1024, 1024};
  pg8::StaticOrder S;
  S.init(NTOK, 1024, gridDim.x, blockIdx.x);
  EpiWout E{p.x_prompt, p.x_sample, (const bf16_t*)p.out, l == 0 ? (bf16_t*)p.out : (bf16_t*)(p.ws + OFF_XN), (const float*)(p.ws + OFF_MODF) + l * 9216, l};
  __syncthreads();
  pg8::gemm_phase<EpiWout, pg8::StaticOrder, true, true>((PG8_LAS unsigned char*)smem, g, S, E);
}

DI void phase_final(const Params& p) {
  const int tid = hide_tid();
  const int wave = tid >> 6, lane = tid & 63;
  for (int row = blockIdx.x * NWAVE + wave; row < NTOK; row += gridDim.x * NWAVE) {
    float* src = p.out + (long)row * 1024;
    const bf16_t* srcb = (const bf16_t*)(p.ws + OFF_XN) + (long)row * 1024;
    f32x4 x[4];
    float ss = 0.f;
#pragma unroll
    for (int j = 0; j < 4; ++j) {
      const u32x2 hw = *(const u32x2*)(srcb + j * 256 + lane * 4);
      x[j] = (f32x4){bf_lo(hw.x), bf_hi(hw.x), bf_lo(hw.y), bf_hi(hw.y)};
      ss += x[j][0] * x[j][0] + x[j][1] * x[j][1] + x[j][2] * x[j][2] + x[j][3] * x[j][3];
    }
    ss = wave_sum(ss);
    const float r = rsqrtf(ss * (1.f / 1024.f) + EPS);
#pragma unroll
    for (int j = 0; j < 4; ++j) {
      const f32x4 g = *(const f32x4*)(p.final_norm_g + j * 256 + lane * 4);
      f32x4 o = {x[j][0] * r * g[0], x[j][1] * r * g[1], x[j][2] * r * g[2], x[j][3] * r * g[3]};
      *(f32x4*)(src + j * 256 + lane * 4) = o;
    }
  }
}

#define XB_TMO      128
#define XB_XCNT(j)  (256  + 64 * (j))
#define XB_XSUB(j)  (1280 + 64 * (j))
#define XB_XGEN(j)  (2304 + 64 * (j))
#define XB_TOP      3328
#define XB_TOPGEN   3392
#define XB_SPIN_CAP (1u << 18)
#define LAS __attribute__((address_space(3)))
DI unsigned xb_ld(unsigned* p)              { return __hip_atomic_load(p, __ATOMIC_RELAXED, __HIP_MEMORY_SCOPE_AGENT); }
DI unsigned xb_add(unsigned* p, unsigned v) { return __hip_atomic_fetch_add(p, v, __ATOMIC_RELAXED, __HIP_MEMORY_SCOPE_AGENT); }
DI unsigned xb_xcc_id() { return (unsigned)__builtin_amdgcn_s_getreg((3 << 11) | 20) & 0xFu; }
#define XB_SPIN(cond, bar) do { unsigned _sp = 0; while (cond) { __builtin_amdgcn_s_sleep(1); \
    if ((++_sp & 255u) == 0u) { if (xb_ld(&(bar)[XB_TMO])) break; if (_sp > XB_SPIN_CAP) { atomicAdd(&(bar)[XB_TMO], 1u); break; } } } } while (0)
struct XcdBarrier { unsigned* bar; unsigned x; volatile LAS unsigned* st; };
DI XcdBarrier xcd_barrier_post(unsigned* bar, volatile LAS unsigned* st) {
  XcdBarrier b; b.bar = bar; b.x = xb_xcc_id(); b.st = st;
  if (threadIdx.x == 0) (void)xb_add(&bar[XB_XCNT(b.x)], 1u);
  return b;
}
DI void xcd_barrier_complete(unsigned* bar, unsigned x, unsigned& nloc, unsigned& nx) {
  const unsigned G = gridDim.x * gridDim.y * gridDim.z;
  unsigned sum, cnt, mine, sp = 0u;
  for (;;) {
    sum = 0u; cnt = 0u; mine = 0u;
#pragma unroll
    for (unsigned j = 0; j < 16; ++j) { const unsigned c = xb_ld(&bar[XB_XCNT(j)]); sum += c; cnt += (c > 0u) ? 1u : 0u; mine = (j == x) ? c : mine; }
    if (sum == G) break;
    __builtin_amdgcn_s_sleep(1);
    if ((++sp & 255u) == 0u) { if (xb_ld(&bar[XB_TMO])) break; if (sp > XB_SPIN_CAP) { atomicAdd(&bar[XB_TMO], 1u); break; } }
  }
  nloc = mine > 0u ? mine : 1u; nx = cnt > 0u ? cnt : 1u;
}
DI void xcd_barrier(unsigned* bar_in, volatile LAS unsigned* st_in) {
  XcdBarrier b; b.bar = bar_in; b.x = xb_xcc_id(); b.st = st_in;
  asm volatile("s_waitcnt vmcnt(0)" ::: "memory");
  __syncthreads();
  if (threadIdx.x == 0) {
    unsigned* bar = b.bar;
    __builtin_amdgcn_s_waitcnt(0);
    unsigned nloc = b.st[0], nx = b.st[1];
    if (nloc == 0u) { xcd_barrier_complete(bar, b.x, nloc, nx); b.st[0] = nloc; b.st[1] = nx; }
    const unsigned old = xb_add(&bar[XB_XSUB(b.x)], 1u);
    const unsigned gen = old / nloc;
    if (old + 1u == (gen + 1u) * nloc) {
      __builtin_amdgcn_fence(__ATOMIC_RELEASE, "agent");
      asm volatile("s_waitcnt vmcnt(0)" ::: "memory");
      const unsigned og = xb_add(&bar[XB_TOP], 1u);
      const unsigned tg = og / nx;
      if (og + 1u == (tg + 1u) * nx) xb_add(&bar[XB_TOPGEN], 1u);
      else XB_SPIN(xb_ld(&bar[XB_TOPGEN]) == tg, bar);
      __builtin_amdgcn_fence(__ATOMIC_ACQUIRE, "agent");
      xb_add(&bar[XB_XGEN(b.x)], 1u);
      asm volatile("s_waitcnt vmcnt(0)" ::: "memory");
    } else {
      XB_SPIN(xb_ld(&bar[XB_XGEN(b.x)]) == gen, bar);
      __builtin_amdgcn_fence(__ATOMIC_ACQUIRE, "agent");
      asm volatile("s_waitcnt vmcnt(0)" ::: "memory");
    }
  }
  __syncthreads();
}

#ifndef PROBE_MASK
#define PROBE_MASK 0
#endif
#define GSYNC() xcd_barrier((unsigned*)(p.ws + OFF_BAR), (volatile LAS unsigned*)&xb_words)
#define PROBE_REP(bit, stmt) do { stmt; if ((PROBE_MASK >> (bit)) & 1) { if (l == 0) { GSYNC(); stmt; } } } while (0)
__global__ void __launch_bounds__(NTHR, 2) fwd_mega(Params p) {
  cg::grid_group grid = cg::this_grid();
  extern __shared__ __attribute__((aligned(16))) unsigned char smem[];
  __shared__ uint4 xb_words;
  if (threadIdx.x == 0) xb_words = make_uint4(0u, 0u, 0u, 0u);
  __syncthreads();
  (void)xcd_barrier_post((unsigned*)(p.ws + OFF_BAR), (volatile LAS unsigned*)&xb_words);
  if (p.ph_lo) grid.sync();
  phase_prep_a(p, smem);
  GSYNC();
  phase_prep_b(p, smem);
  GSYNC();
  if ((PROBE_MASK >> 8) & 1) { for (int i = 0; i < 20; ++i) GSYNC(); }
  if ((PROBE_MASK >> 9) & 1) { phase_prep_a(p, smem); GSYNC(); phase_prep_b(p, smem); GSYNC(); }
#pragma unroll 1
  for (int l = 0; l < 2; ++l) {
    PROBE_REP(0, phase_xn(p, l));
    GSYNC();
    PROBE_REP(1, phase_win(p, l, smem));
    GSYNC();
    {
      const int G = gridDim.x, nwb = G > 64 ? 64 : G, bid = blockIdx.x;
      if (bid < nwb) phase_win_tail(p, l, smem, nwb);
      if (bid >= nwb || G == nwb) {
        const int first = G == nwb ? bid : bid - nwb, stride = G == nwb ? G : G - nwb;
        phase_lat(p, l, first, stride);
        phase_aux(p, l, smem, first, stride);
      }
    }
    GSYNC();
    PROBE_REP(3, phase_up(p, l, smem));
    GSYNC();
    PROBE_REP(4, phase_mix(p, l, smem));
    GSYNC();
    PROBE_REP(5, phase_merge(p, l, smem));
    GSYNC();
    PROBE_REP(6, phase_wout(p, l, smem));
    GSYNC();
  }
  phase_final(p);
}

extern "C" void kernel_launch(void* const* d_in, const int* in_sizes, int n_in, void* d_out, int out_size,
                              void* d_ws, size_t ws_size, hipStream_t stream) {
  constexpr size_t kDynLds = 131072;
  static int grid_blocks = 0;
  if (!grid_blocks) {
    int dev = 0, cus = 0, per_cu = 0;
    (void)hipGetDevice(&dev);
    (void)hipDeviceGetAttribute(&cus, hipDeviceAttributeMultiprocessorCount, dev);
    (void)hipFuncSetAttribute((const void*)fwd_mega, hipFuncAttributeMaxDynamicSharedMemorySize, (int)kDynLds);
    (void)hipOccupancyMaxActiveBlocksPerMultiprocessor(&per_cu, fwd_mega, NTHR, kDynLds);
    if (per_cu > 1) per_cu = 1;
    if (per_cu < 1) per_cu = 1;
    grid_blocks = cus * per_cu;
  }
  if (ws_size < WS_TOTAL) { fprintf(stderr, "workspace too small: %zu < %zu\n", ws_size, (size_t)WS_TOTAL); return; }
  Params p{};
  const float** f = (const float**)&p;
  for (int i = 0; i < 21; ++i) f[i] = (const float*)d_in[i];
  p.out = (float*)d_out;
  p.ws = (unsigned char*)d_ws;
  (void)hipMemsetAsync((unsigned char*)d_ws + OFF_BAR, 0, BAR_BYTES, stream);
  void* args[] = {&p};
  hipError_t e = hipLaunchCooperativeKernel((void*)fwd_mega, dim3(grid_blocks), dim3(NTHR), args, kDynLds, stream);
  if (e != hipSuccess) fprintf(stderr, "cooperative launch failed: %s (grid %d)\n", hipGetErrorString(e), grid_blocks);
}
```
